# Optimizing an MI355X kernel written in HIP

```python
import math
import jax, jax.numpy as jnp
from jax import lax
import numpy as np

D_MODEL = 1024
BATCH = 2
SEQ = 16384
DEPTH = 4

MIX_WIDTH = D_MODEL
S5_WIDTH = MIX_WIDTH // 2
POOL_WIDTH = MIX_WIDTH - S5_WIDTH
S5_GROUP = 16
S5_GROUPS = S5_WIDTH // S5_GROUP
S5_STATE = 64
DT_MIN = 0.001
DT_MAX = 0.1
POOL_WINDOWS = (2, 4, 8, 16)
POOL_GROUP = POOL_WIDTH // len(POOL_WINDOWS)
ATT_HEAD_DIM = 64
ATT_HEADS = D_MODEL // (2 * ATT_HEAD_DIM)
ATT_V_DIM = 2 * ATT_HEAD_DIM
QK_WIDTH = ATT_HEADS * 2 * ATT_HEAD_DIM
Q_BLOCK = 128
ROPE_THETA = 10000.0
N_EXPERTS = 16
EXPERT_FF = 2 * D_MODEL
CAPACITY_FACTOR = 2
EPS = 1e-6
N_EVEN = (DEPTH + 1) // 2
N_ODD = DEPTH // 2

kernel_name = 'hybrid_s5_pool_diffattn_ec_moe'

F32 = jnp.float32


def rmsnorm(x, g):
    xf = x.astype(F32)
    y = xf * lax.rsqrt(jnp.mean(xf * xf, axis=-1, keepdims=True) + EPS)
    return (y * g.astype(F32)).astype(x.dtype)


def rope_tables(positions, dim):
    inv = ROPE_THETA ** (-jnp.arange(0, dim, 2, dtype=F32) / dim)
    ang = positions.astype(F32)[..., None] * inv
    return jnp.cos(ang), jnp.sin(ang)


def apply_rope(x, cos, sin):
    x1, x2 = jnp.split(x, 2, axis=-1)
    c = cos[:, :, None, None, :]
    s = sin[:, :, None, None, :]
    return jnp.concatenate([x1 * c - x2 * s, x1 * s + x2 * c], axis=-1).astype(x.dtype)


def _ssm_combine(left, right):
    a_l, b_l = left
    a_r, b_r = right
    return a_r * a_l, a_r * b_l + b_r


def s5_direction(u, lam_re, lam_im, log_dt, b_re, b_im, c_re, c_im, reverse):
    lam = lax.complex(lam_re.astype(F32), lam_im.astype(F32))
    dt = jnp.exp(log_dt.astype(F32))[:, None]
    a_bar = jnp.exp(lam * dt)
    b = lax.complex(b_re.astype(F32), b_im.astype(F32))
    b_bar = ((a_bar - 1.0) / lam)[..., None] * b
    bu = jnp.einsum('bsgc,gpc->bsgp', u.astype(jnp.complex64), b_bar)
    a = jnp.broadcast_to(a_bar, bu.shape)
    _, h = lax.associative_scan(_ssm_combine, (a, bu), reverse=reverse, axis=1)
    c = lax.complex(c_re.astype(F32), c_im.astype(F32))
    return jnp.einsum('bsgp,gcp->bsgc', h, c).real


def s5_mixer(u, lam_re, lam_im, log_dt, b_re, b_im, c_re, c_im, d_skip, w_glu, b_glu):
    bsz, seq, _ = u.shape
    uf = u.astype(F32)
    ug = uf.reshape(bsz, seq, S5_GROUPS, S5_GROUP)
    y = d_skip.astype(F32) * uf
    for direction, rev in ((0, False), (1, True)):
        y = y + s5_direction(ug, lam_re[direction], lam_im[direction], log_dt[direction],
                             b_re[direction], b_im[direction], c_re[direction], c_im[direction],
                             rev).reshape(bsz, seq, S5_WIDTH)
    y = jax.nn.gelu(y)
    y = y * jax.nn.sigmoid(y @ w_glu.astype(F32) + b_glu.astype(F32))
    return y.astype(u.dtype)


def pool_mixer(v, w_group, scale):
    bsz, seq, _ = v.shape
    vf = v.astype(F32)
    cs = jnp.concatenate([jnp.zeros((bsz, 1, POOL_WIDTH), F32), lax.cumsum(vf, axis=1)], axis=1)
    t = jnp.arange(seq)
    outs = []
    for gi, win in enumerate(POOL_WINDOWS):
        lo = jnp.clip(t - win // 2, 0, seq)
        hi = jnp.clip(t + win // 2, 0, seq)
        sl = slice(gi * POOL_GROUP, (gi + 1) * POOL_GROUP)
        csg = cs[:, :, sl]
        cnt = (hi - lo).astype(F32)[None, :, None]
        outs.append((csg[:, hi] - csg[:, lo]) / cnt - vf[:, :, sl])
    pooled = jnp.stack(outs, axis=2)
    y = jnp.einsum('bsgc,gcd->bsgd', pooled, w_group.astype(F32)).reshape(bsz, seq, POOL_WIDTH)
    return (y * scale.astype(F32)).astype(v.dtype)


def diff_attention(h, cos, sin, w_qkv, w_out, q_norm_g, k_norm_g, lam_q1, lam_k1, lam_q2, lam_k2,
                   subln_g, layer_idx):
    bsz, seq, _ = h.shape
    nb = seq // Q_BLOCK
    qkv = h @ w_qkv
    q, k, v = jnp.split(qkv, [QK_WIDTH, 2 * QK_WIDTH], axis=-1)
    q = q.reshape(bsz, seq, ATT_HEADS, 2, ATT_HEAD_DIM)
    k = k.reshape(bsz, seq, ATT_HEADS, 2, ATT_HEAD_DIM)
    v = v.reshape(bsz, seq, ATT_HEADS, ATT_V_DIM)
    q = apply_rope(rmsnorm(q, q_norm_g), cos, sin)
    k = apply_rope(rmsnorm(k, k_norm_g), cos, sin)
    lam_init = 0.8 - 0.6 * math.exp(-0.3 * layer_idx)
    lam = (jnp.exp(jnp.sum(lam_q1.astype(F32) * lam_k1.astype(F32)))
           - jnp.exp(jnp.sum(lam_q2.astype(F32) * lam_k2.astype(F32))) + lam_init)
    qb = (q * (ATT_HEAD_DIM ** -0.5)).reshape(bsz, nb, Q_BLOCK, ATT_HEADS, 2, ATT_HEAD_DIM)
    qb = qb.transpose(1, 0, 3, 4, 2, 5)
    kt = k.transpose(0, 2, 3, 1, 4)
    vt = v.transpose(0, 2, 1, 3)

    def block(qblk):
        s = jnp.einsum('bhtqd,bhtkd->bhtqk', qblk, kt).astype(F32)
        p = jax.nn.softmax(s, axis=-1)
        p = p[:, :, 0] - lam * p[:, :, 1]
        return jnp.einsum('bhqk,bhkd->bhqd', p.astype(vt.dtype), vt)

    o = lax.map(block, qb)
    o = o.transpose(1, 0, 3, 2, 4).reshape(bsz, seq, ATT_HEADS, ATT_V_DIM)
    o = rmsnorm(o, subln_g) * (1.0 - lam_init)
    return o.reshape(bsz, seq, ATT_HEADS * ATT_V_DIM) @ w_out


def expert_choice_ffn(h, w_router, w_gate, w_up, w_down):
    bsz, seq, _ = h.shape
    cap = CAPACITY_FACTOR * seq // N_EXPERTS
    aff = jax.nn.softmax((h @ w_router).astype(F32), axis=-1)
    gate, idx = lax.top_k(aff.transpose(0, 2, 1), cap)
    b_idx = jnp.arange(bsz)[:, None, None]
    xg = h[b_idx, idx]
    a = jnp.einsum('becd,edf->becf', xg, w_gate)
    u = jnp.einsum('becd,edf->becf', xg, w_up)
    y = jnp.einsum('becf,efd->becd', jax.nn.silu(a) * u, w_down)
    y = y * gate[..., None].astype(y.dtype)
    return jnp.zeros_like(h).at[b_idx, idx].add(y)


def setup_inputs(seed: int = 0) -> dict:
    key = jax.random.key(seed)
    ks = jax.random.split(key, 32)
    nrm = lambda k, shape, std: jax.random.normal(k, shape, F32) * std
    out_scale = (2 * DEPTH) ** -0.5
    n_idx = jnp.arange(S5_STATE, dtype=F32)
    lam_re = -0.5 + nrm(ks[5], (N_EVEN, 2, S5_GROUPS, S5_STATE), 0.01)
    lam_im = jnp.pi * n_idx + nrm(ks[6], (N_EVEN, 2, S5_GROUPS, S5_STATE), 0.01)
    log_dt = jax.random.uniform(ks[7], (N_EVEN, 2, S5_GROUPS), F32, math.log(DT_MIN), math.log(DT_MAX))
    return {
        'x': nrm(ks[0], (BATCH, SEQ, D_MODEL), 1.0),
        'positions': jnp.broadcast_to(jnp.arange(SEQ, dtype=jnp.int32), (BATCH, SEQ)),
        'norm_mix_g': 1.0 + nrm(ks[1], (DEPTH, D_MODEL), 0.02),
        'norm_ffn_g': 1.0 + nrm(ks[2], (DEPTH, D_MODEL), 0.02),
        'hyb_w_in': nrm(ks[3], (N_EVEN, D_MODEL, MIX_WIDTH), D_MODEL ** -0.5),
        'hyb_w_out': nrm(ks[4], (N_EVEN, MIX_WIDTH, D_MODEL), MIX_WIDTH ** -0.5 * out_scale),
        's5_lam_re': lam_re,
        's5_lam_im': lam_im,
        's5_log_dt': log_dt,
        's5_b_re': nrm(ks[8], (N_EVEN, 2, S5_GROUPS, S5_STATE, S5_GROUP), (2 * S5_GROUP) ** -0.5),
        's5_b_im': nrm(ks[9], (N_EVEN, 2, S5_GROUPS, S5_STATE, S5_GROUP), (2 * S5_GROUP) ** -0.5),
        's5_c_re': nrm(ks[10], (N_EVEN, 2, S5_GROUPS, S5_GROUP, S5_STATE), (2 * S5_STATE) ** -0.5),
        's5_c_im': nrm(ks[11], (N_EVEN, 2, S5_GROUPS, S5_GROUP, S5_STATE), (2 * S5_STATE) ** -0.5),
        's5_d': nrm(ks[12], (N_EVEN, S5_WIDTH), 1.0),
        's5_w_glu': nrm(ks[13], (N_EVEN, S5_WIDTH, S5_WIDTH), S5_WIDTH ** -0.5),
        's5_b_glu': nrm(ks[14], (N_EVEN, S5_WIDTH), 0.01),
        'pool_w': nrm(ks[15], (N_EVEN, len(POOL_WINDOWS), POOL_GROUP, POOL_GROUP), POOL_GROUP ** -0.5),
        'pool_scale': 1.0 + nrm(ks[16], (N_EVEN, POOL_WIDTH), 0.02),
        'attn_w_qkv': nrm(ks[17], (N_ODD, D_MODEL, 2 * QK_WIDTH + ATT_HEADS * ATT_V_DIM), D_MODEL ** -0.5),
        'attn_w_out': nrm(ks[18], (N_ODD, ATT_HEADS * ATT_V_DIM, D_MODEL), (ATT_HEADS * ATT_V_DIM) ** -0.5 * out_scale),
        'attn_q_norm_g': 1.0 + nrm(ks[19], (N_ODD, ATT_HEAD_DIM), 0.02),
        'attn_k_norm_g': 1.0 + nrm(ks[20], (N_ODD, ATT_HEAD_DIM), 0.02),
        'attn_lam_q1': nrm(ks[21], (N_ODD, ATT_HEAD_DIM), 0.1),
        'attn_lam_k1': nrm(ks[22], (N_ODD, ATT_HEAD_DIM), 0.1),
        'attn_lam_q2': nrm(ks[23], (N_ODD, ATT_HEAD_DIM), 0.1),
        'attn_lam_k2': nrm(ks[24], (N_ODD, ATT_HEAD_DIM), 0.1),
        'attn_subln_g': 1.0 + nrm(ks[25], (N_ODD, ATT_V_DIM), 0.02),
        'moe_w_router': nrm(ks[26], (DEPTH, D_MODEL, N_EXPERTS), D_MODEL ** -0.5),
        'moe_w_gate': nrm(ks[27], (DEPTH, N_EXPERTS, D_MODEL, EXPERT_FF), D_MODEL ** -0.5),
        'moe_w_up': nrm(ks[28], (DEPTH, N_EXPERTS, D_MODEL, EXPERT_FF), D_MODEL ** -0.5),
        'moe_w_down': nrm(ks[29], (DEPTH, N_EXPERTS, EXPERT_FF, D_MODEL), EXPERT_FF ** -0.5 * out_scale),
    }


def reference(x, positions, norm_mix_g, norm_ffn_g, hyb_w_in, hyb_w_out, s5_lam_re, s5_lam_im,
              s5_log_dt, s5_b_re, s5_b_im, s5_c_re, s5_c_im, s5_d, s5_w_glu, s5_b_glu, pool_w,
              pool_scale, attn_w_qkv, attn_w_out, attn_q_norm_g, attn_k_norm_g, attn_lam_q1,
              attn_lam_k1, attn_lam_q2, attn_lam_k2, attn_subln_g, moe_w_router, moe_w_gate,
              moe_w_up, moe_w_down):
    cos, sin = rope_tables(positions, ATT_HEAD_DIM)
    h = x
    for layer in range(DEPTH):
        n = rmsnorm(h, norm_mix_g[layer])
        if layer % 2 == 0:
            e = layer // 2
            z = n @ hyb_w_in[e]
            ya = s5_mixer(z[..., :S5_WIDTH], s5_lam_re[e], s5_lam_im[e], s5_log_dt[e],
                          s5_b_re[e], s5_b_im[e], s5_c_re[e], s5_c_im[e], s5_d[e],
                          s5_w_glu[e], s5_b_glu[e])
            yb = pool_mixer(z[..., S5_WIDTH:], pool_w[e], pool_scale[e])
            mix = jnp.concatenate([ya, yb], axis=-1) @ hyb_w_out[e]
        else:
            o = layer // 2
            mix = diff_attention(n, cos, sin, attn_w_qkv[o], attn_w_out[o], attn_q_norm_g[o],
                                 attn_k_norm_g[o], attn_lam_q1[o], attn_lam_k1[o], attn_lam_q2[o],
                                 attn_lam_k2[o], attn_subln_g[o], layer)
        h = h + mix
        h = h + expert_choice_ffn(rmsnorm(h, norm_ffn_g[layer]), moe_w_router[layer],
                                  moe_w_gate[layer], moe_w_up[layer], moe_w_down[layer])
    return h
```

```cpp
#include <hip/hip_runtime.h>
#include <cstdio>
#include <cstdint>

#define GAS __attribute__((address_space(1)))
#define LAS __attribute__((address_space(3)))
typedef unsigned short bf16_t;
typedef short bf16x8 __attribute__((ext_vector_type(8)));
typedef short s16x4 __attribute__((ext_vector_type(4)));
typedef float f32x4 __attribute__((ext_vector_type(4)));
typedef float f32x2 __attribute__((ext_vector_type(2)));
typedef float f32x16 __attribute__((ext_vector_type(16)));
typedef unsigned u32x4 __attribute__((ext_vector_type(4)));
typedef unsigned u32x2 __attribute__((ext_vector_type(2)));
typedef int i32x4 __attribute__((ext_vector_type(4)));

#ifndef DBG_LAYERS
#define DBG_LAYERS 4
#endif
#ifndef DBG_MIX
#define DBG_MIX 1
#endif
#ifndef DBG_MOE
#define DBG_MOE 1
#endif
#ifndef DBG_PH
#define DBG_PH 0xFFFFFFFFu
#endif
#define PH(k) ((DBG_PH >> (k)) & 1u)
#ifndef DBG_REP
#define DBG_REP 0u
#endif
#define REP(k) for (int rep_ = 0; rep_ < 1 + (int)((DBG_REP >> (k)) & 1u); ++rep_)

constexpr int DM = 1024, BATCH = 2, SEQ = 16384, TOK = BATCH * SEQ, NE = 16, FF = 2048, CAP = 2048, NROW = BATCH * NE * CAP;
constexpr int NWAVES = 8, NTHR = 512, GRID = 256;
constexpr float EPS = 1e-6f;
constexpr float LOG2E = 1.4426950408889634f;
constexpr float QSCALE = 0.125f * LOG2E;

constexpr size_t MiB = 1u << 20;
constexpr size_t WS_CTL = 0, CTL_ZERO_BYTES = 1 * MiB;
constexpr size_t WS_COS = 2 * MiB, WS_SIN = 6 * MiB;
constexpr size_t WS_AFF = 10 * MiB;
constexpr size_t WS_SLOT = 12 * MiB;
constexpr size_t WS_IDX = 14 * MiB;
constexpr size_t WS_GATE = 14 * MiB + 512 * 1024;
constexpr size_t WS_AL = 15 * MiB;
constexpr size_t WS_KBUF = 16 * MiB;
constexpr size_t WS_WIN = 20 * MiB;
constexpr size_t WS_WOUT = 26 * MiB;
constexpr size_t WS_WGP = 28 * MiB;
constexpr size_t WS_WST = 32 * MiB;
constexpr size_t WS_BTM = 48 * MiB;
constexpr size_t WS_BT1 = 128 * MiB;
constexpr size_t WS_BT2 = 256 * MiB;
constexpr size_t WS_RSMOE = 832 * MiB;
constexpr size_t WS_H = 320 * MiB;
constexpr size_t WS_N = 448 * MiB;
constexpr size_t WS_ZS5 = 512 * MiB;
constexpr size_t WS_ZP = 576 * MiB;
constexpr size_t WS_SPART = 640 * MiB;
constexpr size_t WS_Q = WS_ZS5, WS_K = WS_ZP, WS_V = WS_SPART;
constexpr size_t WS_YC = 704 * MiB;
constexpr size_t WS_MIX = 768 * MiB;
constexpr size_t WS_XG = 832 * MiB;
constexpr size_t WS_HMID = 960 * MiB;
constexpr size_t WS_YB = 1216 * MiB;
constexpr size_t WS_END = 1344 * MiB;
constexpr int CW_BAR = 4096;

constexpr int RING_BYTES = 131072;
constexpr int LDSCTL_OFF = RING_BYTES, MISC_OFF = LDSCTL_OFF + 320;
constexpr int GTAB_OFF = 133120;
constexpr int LDS_BYTES = 151552;

constexpr int PTAB_OFF = LDSCTL_OFF + 512;
__device__ __forceinline__ const void* getp(const unsigned char* lds_raw_, int k) {
    const LAS unsigned* t = (const LAS unsigned*)((const LAS unsigned char*)lds_raw_ + PTAB_OFF) + 2 * k;
    const unsigned lo = __builtin_amdgcn_readfirstlane(t[0]), hi = __builtin_amdgcn_readfirstlane(t[1]);
    return (const void*)(const GAS void*)(((unsigned long long)hi << 32) | lo);
}
#define RLX_AGENT __ATOMIC_RELAXED, __HIP_MEMORY_SCOPE_AGENT
#define LDS_WAIT() asm volatile("s_waitcnt lgkmcnt(0)" ::: "memory")
#define VM_WAIT() asm volatile("s_waitcnt vmcnt(0)" ::: "memory")
__device__ __forceinline__ unsigned cvt_pk_bf16(float lo, float hi) { unsigned r; asm volatile("v_cvt_pk_bf16_f32 %0, %1, %2" : "=v"(r) : "v"(lo), "v"(hi)); return r; }
__device__ __forceinline__ unsigned f2bf(float f) { return cvt_pk_bf16(f, 0.f) & 0xffffu; }
__device__ __forceinline__ float bf_lo(unsigned w) { return __uint_as_float(w << 16); }
__device__ __forceinline__ float bf_hi(unsigned w) { return __uint_as_float(w & 0xffff0000u); }
__device__ __forceinline__ float wave_sum(float v) {
#pragma unroll
    for (int o = 1; o < 64; o <<= 1) v += __shfl_xor(v, o);
    return v;
}
__device__ __forceinline__ float fast_exp2(float x) { return __builtin_amdgcn_exp2f(x); }
__device__ __forceinline__ float fast_rcp(float x) { return __builtin_amdgcn_rcpf(x); }
__device__ __forceinline__ float sigmoidf_fast(float x) { return fast_rcp(1.0f + fast_exp2(-x * LOG2E)); }
__device__ __forceinline__ float gelu_tanh(float y) { const float u = 0.7978845608028654f * (y + 0.044715f * y * y * y); return y * sigmoidf_fast(2.0f * u); }
__device__ __forceinline__ void sincos_big(double ang, float& s, float& c) {
    const double rev = ang * 0.15915494309189533577; const double fr = rev - __builtin_rint(rev); const float f = (float)fr;
    s = __builtin_amdgcn_sinf(f); c = __builtin_amdgcn_cosf(f);
}

#define XB_TMO      128
#define XB_XCNT(j)  (256  + 64 * (j))
#define XB_XSUB(j)  (1280 + 64 * (j))
#define XB_XGEN(j)  (2304 + 64 * (j))
#define XB_TOP      3328
#define XB_TOPGEN   3392
#define XCD_BAR_WORDS 3456
#define XB_SPIN_CAP (1u << 22)
__device__ __forceinline__ unsigned xb_ld(unsigned* p)              { return __hip_atomic_load(p, __ATOMIC_RELAXED, __HIP_MEMORY_SCOPE_AGENT); }
__device__ __forceinline__ unsigned xb_add(unsigned* p, unsigned v) { return __hip_atomic_fetch_add(p, v, __ATOMIC_RELAXED, __HIP_MEMORY_SCOPE_AGENT); }
__device__ __forceinline__ unsigned xb_xcc_id() { return (unsigned)__builtin_amdgcn_s_getreg((3 << 11) | 20) & 0xFu; }
#define XB_SPIN(cond, bar) do { unsigned _sp = 0; while (cond) { __builtin_amdgcn_s_sleep(1); \
    if ((++_sp & 255u) == 0u) { if (xb_ld(&(bar)[XB_TMO])) break; if (_sp > XB_SPIN_CAP) { atomicAdd(&(bar)[XB_TMO], 1u); break; } } } } while (0)
struct XcdBarrier { unsigned* bar; unsigned x; volatile LAS unsigned* st; };
__device__ __forceinline__ XcdBarrier xcd_barrier_post(unsigned* bar, volatile LAS unsigned* st) {
    XcdBarrier b; b.bar = bar; b.x = xb_xcc_id(); b.st = st;
    if (threadIdx.x == 0) (void)xb_add(&bar[XB_XCNT(b.x)], 1u);
    return b;
}
__device__ __forceinline__ void xcd_barrier_complete(unsigned* bar, unsigned x, unsigned& nloc, unsigned& nx) {
    const unsigned G = gridDim.x * gridDim.y * gridDim.z;
    unsigned sum, cnt, mine, sp = 0u;
    for (;;) {
        sum = 0u; cnt = 0u; mine = 0u;
#pragma unroll
        for (unsigned j = 0; j < 16; ++j) { const unsigned c = xb_ld(&bar[XB_XCNT(j)]); sum += c; cnt += (c > 0u) ? 1u : 0u; mine = (j == x) ? c : mine; }
        if (sum == G) break;
        __builtin_amdgcn_s_sleep(1);
        if ((++sp & 255u) == 0u) { if (xb_ld(&bar[XB_TMO])) break; if (sp > XB_SPIN_CAP) { atomicAdd(&bar[XB_TMO], 1u); break; } }
    }
    nloc = mine > 0u ? mine : 1u; nx = cnt > 0u ? cnt : 1u;
}
__device__ __forceinline__ void xcd_barrier(const XcdBarrier& b) {
    asm volatile("s_waitcnt vmcnt(0)" ::: "memory");
    __syncthreads();
    if (threadIdx.x == 0) {
        unsigned* bar = b.bar;
        __builtin_amdgcn_s_waitcnt(0);
        unsigned nloc = b.st[0], nx = b.st[1];
        if (nloc == 0u) { xcd_barrier_complete(bar, b.x, nloc, nx); b.st[0] = nloc; b.st[1] = nx; }
        const unsigned old = xb_add(&bar[XB_XSUB(b.x)], 1u);
        const unsigned gen = old / nloc;
        if (old + 1u == (gen + 1u) * nloc) {
            __builtin_amdgcn_fence(__ATOMIC_RELEASE, "agent");
            asm volatile("s_waitcnt vmcnt(0)" ::: "memory");
            const unsigned og = xb_add(&bar[XB_TOP], 1u);
            const unsigned tg = og / nx;
            if (og + 1u == (tg + 1u) * nx) xb_add(&bar[XB_TOPGEN], 1u);
            else XB_SPIN(xb_ld(&bar[XB_TOPGEN]) == tg, bar);
            __builtin_amdgcn_fence(__ATOMIC_ACQUIRE, "agent");
            xb_add(&bar[XB_XGEN(b.x)], 1u);
            asm volatile("s_waitcnt vmcnt(0)" ::: "memory");
        } else {
            XB_SPIN(xb_ld(&bar[XB_XGEN(b.x)]) == gen, bar);
            __builtin_amdgcn_fence(__ATOMIC_ACQUIRE, "agent");
            asm volatile("s_waitcnt vmcnt(0)" ::: "memory");
        }
    }
    __syncthreads();
}

__device__ __forceinline__ void glds16_sv(unsigned voff, const char* sbase, unsigned lds_dst) {
    asm volatile("s_mov_b32 m0, %2\n\ts_nop 0\n\tglobal_load_lds_dwordx4 %0, %1" : : "v"(voff), "s"(sbase), "s"(lds_dst) : "memory", "m0"); }
__device__ __forceinline__ void glds16_sv2(unsigned voff0, unsigned voff1, const char* sbase, unsigned lds_dst) { unsigned t_;
    asm volatile("s_mov_b32 m0, %4\n\ts_add_i32 %0, %4, 0x2000\n\tglobal_load_lds_dwordx4 %1, %3\n\ts_mov_b32 m0, %0\n\ts_nop 0\n\tglobal_load_lds_dwordx4 %2, %3"
                 : "=&s"(t_) : "v"(voff0), "v"(voff1), "s"(sbase), "s"(lds_dst) : "memory", "m0", "scc"); }
namespace pg8 {
constexpr int BM = 256, BK = 64, HALF = 128, HTB = HALF * BK * 2, STAGE_BYTES = 8 * HTB;
__host__ __device__ __forceinline__ int lds_byte(int r, int c) { const int st = (r >> 4) * 2 + (c >> 5), rr = r & 15, cc = c & 31, ob = rr * 64 + cc * 2; return st * 1024 + (ob ^ (((ob >> 9) & 1) << 5)); }
__host__ __device__ __forceinline__ void stage_rc(int b, int& R, int& C) { const int st = b / 1024, sb = b % 1024, swz = sb ^ (((sb >> 9) & 1) << 5); R = (st >> 1) * 16 + swz / 64; C = (st & 1) * 32 + (swz % 64) / 2; }
__host__ __device__ __forceinline__ int perm32(int rho) { const int n = rho >> 4, i = rho & 15; return 8 * (i >> 2) + 4 * n + (i & 3); }

struct Unit { int pm, pn, pg; const char* a; const char* b; };
struct Cfg { unsigned a_row, b_row; int K; };

template <class Epi, class Sched, bool GATHER = false>
__device__ __forceinline__ void gemm_phase(LAS unsigned char* lds, const Cfg g, const Sched& S, const Epi& E, const LAS unsigned* gtab = nullptr) {
    int tid_ = threadIdx.x; asm volatile("" : "+v"(tid_));
    const int tid = tid_, wid = __builtin_amdgcn_readfirstlane(tid >> 6), lane = tid & 63, wr = wid >> 2, wc = wid & 3, fr = lane & 15, fq = lane >> 4;
    int Kr_ = g.K; asm volatile("" : "+s"(Kr_));
    const int nt = Kr_ / BK;
    unsigned vA[2][2], vAn[2][2], voffB[2]; int RA[2], CA2[2];
#pragma unroll
    for (int i = 0; i < 2; ++i) { int R, C; stage_rc(tid * 16 + i * 8192, R, C); const int Rb = Epi::PERM ? ((R & ~31) + perm32(R & 31)) : R; RA[i] = R; CA2[i] = C * 2;
        voffB[i] = (unsigned)Rb * g.b_row + (unsigned)C * 2u;
#pragma unroll
        for (int h = 0; h < 2; ++h) { if constexpr (GATHER) vA[h][i] = gtab[h * HALF + R] + (unsigned)(C * 2); else vA[h][i] = (unsigned)(R + h * HALF) * g.a_row + (unsigned)C * 2u; vAn[h][i] = vA[h][i]; } }
    const size_t kstep = (size_t)(BK * 2);
    const size_t hstepB = (size_t)HALF * g.b_row;
    const unsigned ldsw = (unsigned)wid * 1024u, lds0_ = (unsigned)(size_t)lds;
    const int aoff = lds_byte(wr * 64 + fr, fq * 8), boff = lds_byte(wc * 32 + fr, fq * 8);
#define PG8_SA(b, h) (((b) * 2 + (h)) * HTB)
#define PG8_SB(b, h) ((4 + (b) * 2 + (h)) * HTB)
#define PG8_STAGE(bufoff, gbase, voff) glds16_sv2((voff)[0], (voff)[1], (const char*)(gbase), lds0_ + (unsigned)(bufoff) + ldsw)
#define PG8_LDA(dst, b, h) do { _Pragma("unroll") for (int m = 0; m < 4; ++m) _Pragma("unroll") for (int k = 0; k < 2; ++k) dst[m][k] = *(const LAS bf16x8*)(lds + PG8_SA(b, h) + aoff + m * 2048 + k * 1024); } while (0)
#define PG8_LDB(dst, b, h) do { _Pragma("unroll") for (int n = 0; n < 2; ++n) _Pragma("unroll") for (int k = 0; k < 2; ++k) dst[n][k] = *(const LAS bf16x8*)(lds + PG8_SB(b, h) + boff + n * 2048 + k * 1024); } while (0)
#define PG8_MMA(ai, bj, At, Bt) do { __builtin_amdgcn_s_setprio(1); _Pragma("unroll") for (int m = 0; m < 4; ++m) _Pragma("unroll") for (int n = 0; n < 2; ++n) _Pragma("unroll") for (int k = 0; k < 2; ++k) \
        acc[ai][bj][m][n] = __builtin_amdgcn_mfma_f32_16x16x32_bf16(Bt[n][k], At[m][k], acc[ai][bj][m][n], 0, 0, 0); __builtin_amdgcn_s_setprio(0); } while (0)
#define PG8_WAIT_V(n) asm volatile("s_waitcnt vmcnt(" #n ")" ::: "memory")
#define PG8_WAIT_L(n) asm volatile("s_waitcnt lgkmcnt(" #n ")" ::: "memory")
#define PG8_BAR __builtin_amdgcn_s_barrier()
#define PG8_SCHED __builtin_amdgcn_sched_barrier(0)
    Unit cur, nxt; int ui = 0;
    if (!S.next(0, cur)) return;
    f32x4 acc[2][2][4][2];
#pragma unroll
    for (int a = 0; a < 2; ++a)
#pragma unroll
        for (int b = 0; b < 2; ++b)
#pragma unroll
            for (int m = 0; m < 4; ++m)
#pragma unroll
                for (int n = 0; n < 2; ++n) acc[a][b][m][n] = (f32x4){0.f, 0.f, 0.f, 0.f};
    bf16x8 At[4][2], B0[2][2], B1[2][2];
    const char* cA = cur.a; const char* cB = cur.b;
    PG8_STAGE(PG8_SB(0, 0), cB, voffB); PG8_STAGE(PG8_SB(0, 1), cB + hstepB, voffB); PG8_STAGE(PG8_SA(0, 0), cA, vA[0]); PG8_STAGE(PG8_SA(0, 1), cA, vA[1]);
    if (wr == 1) PG8_BAR;
    PG8_WAIT_V(2); PG8_BAR;
    PG8_STAGE(PG8_SB(1, 0), cB + kstep, voffB); PG8_STAGE(PG8_SA(1, 0), cA + kstep, vA[0]); PG8_STAGE(PG8_SB(1, 1), cB + hstepB + kstep, voffB);
    PG8_WAIT_V(6); PG8_BAR;
    for (;;) {
        const bool has_next = S.next(ui + 1, nxt);
        const char* nA = has_next ? nxt.a : cA; const char* nB = has_next ? nxt.b : cB;
        if constexpr (GATHER) { if (has_next) {
#pragma unroll
            for (int i = 0; i < 2; ++i)
#pragma unroll
                for (int h = 0; h < 2; ++h) vAn[h][i] = gtab[(ui + 1) * BM + h * HALF + RA[i]] + (unsigned)CA2[i]; } }
        for (int t = 0; t < nt; t += 2) {
            const bool last = (t == nt - 2);
            unsigned sA0[2], sA1[2];
#pragma unroll
            for (int i = 0; i < 2; ++i) { if constexpr (GATHER) { sA0[i] = last ? vAn[0][i] : vA[0][i]; sA1[i] = last ? vAn[1][i] : vA[1][i]; } else { sA0[i] = vA[0][i]; sA1[i] = vA[1][i]; } }
            const char* a1 = cA + (size_t)(t + 1) * kstep;
            const char* a2 = last ? nA : cA + (size_t)(t + 2) * kstep; const char* b2 = last ? nB : cB + (size_t)(t + 2) * kstep;
            const char* a3 = a2 + kstep; const char* b3 = b2 + kstep;
            PG8_STAGE(PG8_SA(1, 1), a1, vA[1]); PG8_LDB(B0, 0, 0); PG8_LDB(B1, 0, 1); PG8_SCHED; PG8_LDA(At, 0, 0);
            PG8_WAIT_V(8); PG8_WAIT_L(0); PG8_BAR; PG8_MMA(0, 0, At, B0); PG8_MMA(0, 1, At, B1); PG8_BAR; PG8_SCHED;
            PG8_STAGE(PG8_SB(0, 0), b2, voffB); PG8_STAGE(PG8_SB(0, 1), b2 + hstepB, voffB); PG8_STAGE(PG8_SA(0, 0), a2, sA0); PG8_LDA(At, 0, 1);
            PG8_WAIT_V(8); PG8_WAIT_L(0); PG8_BAR; PG8_MMA(1, 0, At, B0); PG8_MMA(1, 1, At, B1); PG8_BAR; PG8_SCHED;
            PG8_STAGE(PG8_SA(0, 1), a2, sA1); PG8_LDB(B0, 1, 0); PG8_LDB(B1, 1, 1); PG8_SCHED; PG8_LDA(At, 1, 0);
            PG8_WAIT_V(8); PG8_WAIT_L(0); PG8_BAR; PG8_MMA(0, 0, At, B0); PG8_MMA(0, 1, At, B1); PG8_BAR; PG8_SCHED;
            PG8_STAGE(PG8_SB(1, 0), b3, voffB); PG8_STAGE(PG8_SB(1, 1), b3 + hstepB, voffB); PG8_STAGE(PG8_SA(1, 0), a3, sA0); PG8_LDA(At, 1, 1);
            PG8_WAIT_V(8); PG8_WAIT_L(0); PG8_BAR; PG8_MMA(1, 0, At, B0); PG8_MMA(1, 1, At, B1); PG8_BAR; PG8_SCHED;
        }
        if (wr == 0) PG8_BAR;
        E(acc, cur, wr, wc, fr, fq);
        if (!has_next) break;
#pragma unroll
        for (int a = 0; a < 2; ++a)
#pragma unroll
            for (int b = 0; b < 2; ++b)
#pragma unroll
                for (int m = 0; m < 4; ++m)
#pragma unroll
                    for (int n = 0; n < 2; ++n) acc[a][b][m][n] = (f32x4){0.f, 0.f, 0.f, 0.f};
        cur = nxt; cA = nA; cB = nB; ++ui;
        if constexpr (GATHER) {
#pragma unroll
            for (int i = 0; i < 2; ++i) { vA[0][i] = vAn[0][i]; vA[1][i] = vAn[1][i]; } }
        if (wr == 1) PG8_BAR;
    }
    PG8_WAIT_V(0);
    PG8_BAR;
#undef PG8_SA
#undef PG8_SB
#undef PG8_STAGE
#undef PG8_LDA
#undef PG8_LDB
#undef PG8_MMA
#undef PG8_WAIT_V
#undef PG8_WAIT_L
#undef PG8_BAR
#undef PG8_SCHED
}

struct PlainOrder {
    int nM, nN, nwg, G, c; const char* A; const char* B; size_t a_tile, b_tile; int a_pn_split; size_t a_pn_off;
    __device__ void init(int M, int N, int G_, int c_, const void* A_, const void* B_, unsigned a_row, unsigned b_row) {
        nM = M / BM; nN = N / BM; nwg = nM * nN; G = G_; c = c_; A = (const char*)A_; B = (const char*)B_; a_tile = (size_t)BM * a_row; b_tile = (size_t)BM * b_row; a_pn_split = 1 << 30; a_pn_off = 0; }
    __device__ bool next(int i, Unit& u) const {
        const long L = (long)i * G + c; if (L >= nwg) return false;
        int wgid = (int)L; { const int q = nwg / 8, r = nwg % 8, xcd = wgid % 8, off = wgid / 8; wgid = (xcd < r ? xcd * (q + 1) : r * (q + 1) + (xcd - r) * q) + off; }
        const int nig = 8 * nN, gid = wgid / nig, fm = gid * 8, gsz = (nM - fm) < 8 ? (nM - fm) : 8;
        u.pm = fm + ((wgid % nig) % gsz); u.pn = (wgid % nig) / gsz; u.pg = 0;
        u.a = A + (size_t)u.pm * a_tile + (u.pn >= a_pn_split ? a_pn_off : 0); u.b = B + (size_t)u.pn * b_tile; return true;
    }
};
struct S5Order {
    int G, c; const char* A; const char* B; size_t a_g, a_tile, b_g; size_t a_q, b_q;
    __device__ bool next(int i, Unit& u) const {
        const int L = i * G + c; if (L >= 256) return false;
        u.pg = L >> 3; u.pm = (L >> 2) & 1; u.pn = L & 3;
        u.a = A + (size_t)u.pg * a_g + (size_t)u.pm * a_tile + (size_t)u.pn * a_q; u.b = B + (size_t)u.pg * b_g + (size_t)u.pn * b_q; return true;
    }
};
struct Moe1Order {
    int G, c; const char* A; const char* B; int e0, ne;
    __device__ bool next(int i, Unit& u) const {
        const int L = i * G + c; if (L >= ne * 256) return false;
        const int e = e0 + (L >> 8), w = L & 255, xcd = w >> 5, j = w & 31;
        const int pml = (xcd >> 1) * 4 + (j >> 3), pn = (xcd & 1) * 8 + (j & 7);
        u.pg = e; u.pm = e * 16 + pml; u.pn = pn;
        u.a = A; u.b = B + (size_t)e * (4096u * 2048u) + (size_t)pn * (256u * 2048u); return true;
    }
};
struct Moe2Order {
    int G, c; const char* A; const char* B; int e0, ne;
    __device__ bool next(int i, Unit& u) const {
        const int L = i * G + c; if (L >= ne * 64) return false;
        const int e = e0 + (L >> 6), w = L & 63;
        u.pg = e; u.pm = e * 16 + (w >> 2); u.pn = w & 3;
        u.a = A + (size_t)u.pm * (256u * 4096u); u.b = B + (size_t)e * (1024u * 4096u) + (size_t)u.pn * (256u * 4096u); return true;
    }
};

struct EpiBf16 {
    static constexpr bool PERM = true;
    bf16_t* O; int ldc; int split_cols; size_t split_stride;
    __device__ __forceinline__ void operator()(const f32x4 (&acc)[2][2][4][2], const Unit& u, int wr, int wc, int fr, int fq) const {
        const int row0 = u.pm * BM + wr * 64 + fr; int colt = u.pn * BM; bf16_t* base = O;
        if (split_cols) { const int t = colt / split_cols; base += (size_t)t * split_stride; colt -= t * split_cols; }
        const int col0 = colt + wc * 32 + 8 * fq;
#pragma unroll
        for (int ai = 0; ai < 2; ++ai)
#pragma unroll
            for (int m = 0; m < 4; ++m) { bf16_t* rowp = base + (size_t)(row0 + ai * HALF + m * 16) * ldc + col0;
#pragma unroll
                for (int bj = 0; bj < 2; ++bj) { const f32x4 v0 = acc[ai][bj][m][0], v1 = acc[ai][bj][m][1];
                    u32x4 w; w.x = cvt_pk_bf16(v0[0], v0[1]); w.y = cvt_pk_bf16(v0[2], v0[3]); w.z = cvt_pk_bf16(v1[0], v1[1]); w.w = cvt_pk_bf16(v1[2], v1[3]);
                    *(u32x4*)(rowp + bj * HALF) = w; } }
    }
};
struct EpiQKV {
    static constexpr bool PERM = true;
    bf16_t* O; size_t split_stride; const float* cs; const float* sn; const float* qg; const float* kg; LAS float* P;
    __device__ __forceinline__ void operator()(const f32x4 (&acc)[2][2][4][2], const Unit& u, int wr, int wc, int fr_, int fq_) const {
        int fr = fr_, fq = fq_; asm volatile("" : "+v"(fr), "+v"(fq));
        const int row0 = u.pm * BM + wr * 64 + fr; const int t = u.pn >> 2; const int colt = (u.pn & 3) * BM; bf16_t* base = O + (size_t)t * split_stride;
        const int col0 = colt + wc * 32 + 8 * fq;
        if (t < 2) {
            const int i0 = 16 * (wc & 1) + 4 * fq;
            f32x4 c4a[8], s4a[8];
#pragma unroll
            for (int ai = 0; ai < 2; ++ai)
#pragma unroll
                for (int m = 0; m < 4; ++m) { const int row = row0 + ai * HALF + m * 16; c4a[ai * 4 + m] = *(const f32x4*)(cs + (size_t)row * 32 + i0); s4a[ai * 4 + m] = *(const f32x4*)(sn + (size_t)row * 32 + i0); }
#pragma unroll
            for (int ai = 0; ai < 2; ++ai)
#pragma unroll
                for (int m = 0; m < 4; ++m) {
#pragma unroll
                    for (int bj = 0; bj < 2; ++bj) { const f32x4 v0 = acc[ai][bj][m][0], v1 = acc[ai][bj][m][1];
                        float sq = (v0[0] * v0[0] + v0[1] * v0[1]) + (v0[2] * v0[2] + v0[3] * v0[3]) + (v1[0] * v1[0] + v1[1] * v1[1]) + (v1[2] * v1[2] + v1[3] * v1[3]);
                        sq += __shfl_xor(sq, 16); sq += __shfl_xor(sq, 32);
                        if (fq == 0) P[(ai * HALF + wr * 64 + m * 16 + fr) * 8 + bj * 4 + wc] = sq; }
                    asm volatile("" ::: "memory"); }
            asm volatile("s_waitcnt lgkmcnt(0)" ::: "memory"); __builtin_amdgcn_s_barrier(); asm volatile("" ::: "memory");
            const float* g = t ? kg : qg; const float sc = t ? 1.0f : QSCALE;
            const f32x4 g1 = *(const f32x4*)(g + i0) * sc, g2 = *(const f32x4*)(g + 32 + i0) * sc;
#pragma unroll
            for (int ai = 0; ai < 2; ++ai)
#pragma unroll
                for (int m = 0; m < 4; ++m) { const int rl = ai * HALF + wr * 64 + m * 16 + fr; const int row = row0 + ai * HALF + m * 16; bf16_t* rowp = base + (size_t)row * 1024 + col0;
                    const f32x4 c4 = c4a[ai * 4 + m], s4 = s4a[ai * 4 + m];
#pragma unroll
                    for (int bj = 0; bj < 2; ++bj) { const f32x4 v0 = acc[ai][bj][m][0], v1 = acc[ai][bj][m][1];
                        const float tot = P[rl * 8 + bj * 4 + wc] + P[rl * 8 + bj * 4 + (wc ^ 1)]; const float rstd = __builtin_amdgcn_rsqf(tot * (1.0f / 64.0f) + EPS);
                        const float a0 = v0[0] * rstd * g1[0], b0 = v0[1] * rstd * g2[0], a1 = v0[2] * rstd * g1[1], b1 = v0[3] * rstd * g2[1];
                        const float a2 = v1[0] * rstd * g1[2], b2 = v1[1] * rstd * g2[2], a3 = v1[2] * rstd * g1[3], b3 = v1[3] * rstd * g2[3];
                        u32x4 w; w.x = cvt_pk_bf16(a0 * c4[0] - b0 * s4[0], a0 * s4[0] + b0 * c4[0]); w.y = cvt_pk_bf16(a1 * c4[1] - b1 * s4[1], a1 * s4[1] + b1 * c4[1]);
                        w.z = cvt_pk_bf16(a2 * c4[2] - b2 * s4[2], a2 * s4[2] + b2 * c4[2]); w.w = cvt_pk_bf16(a3 * c4[3] - b3 * s4[3], a3 * s4[3] + b3 * c4[3]);
                        *(u32x4*)(rowp + bj * HALF) = w; }
                    asm volatile("" ::: "memory"); }
        } else {
            __builtin_amdgcn_s_barrier();
#pragma unroll
            for (int ai = 0; ai < 2; ++ai)
#pragma unroll
                for (int m = 0; m < 4; ++m) { bf16_t* rowp = base + (size_t)(row0 + ai * HALF + m * 16) * 1024 + col0;
#pragma unroll
                    for (int bj = 0; bj < 2; ++bj) { const f32x4 v0 = acc[ai][bj][m][0], v1 = acc[ai][bj][m][1];
                        u32x4 w; w.x = cvt_pk_bf16(v0[0], v0[1]); w.y = cvt_pk_bf16(v0[2], v0[3]); w.z = cvt_pk_bf16(v1[0], v1[1]); w.w = cvt_pk_bf16(v1[2], v1[3]);
                        *(u32x4*)(rowp + bj * HALF) = w; } }
        }
    }
};
struct EpiZ {
    static constexpr bool PERM = true;
    bf16_t* zs5; bf16_t* zp;
    __device__ __forceinline__ void operator()(const f32x4 (&acc)[2][2][4][2], const Unit& u, int wr, int wc, int fr, int fq) const {
        const int row0 = u.pm * BM + wr * 64 + fr;
#pragma unroll
        for (int ai = 0; ai < 2; ++ai)
#pragma unroll
            for (int m = 0; m < 4; ++m) { const int row = row0 + ai * HALF + m * 16;
#pragma unroll
                for (int bj = 0; bj < 2; ++bj) { const f32x4 v0 = acc[ai][bj][m][0], v1 = acc[ai][bj][m][1];
                    u32x4 w; w.x = cvt_pk_bf16(v0[0], v0[1]); w.y = cvt_pk_bf16(v0[2], v0[3]); w.z = cvt_pk_bf16(v1[0], v1[1]); w.w = cvt_pk_bf16(v1[2], v1[3]);
                    const int col = u.pn * BM + bj * HALF + wc * 32 + 8 * fq;
                    if (u.pn < 2) { const int g = col >> 4, c = col & 15, R = row >> 6, i = row & 63;
                        *(u32x4*)(zs5 + ((size_t)(g * 512 + R) * 1280 + i * 16 + c)) = w; }
                    else *(u32x4*)(zp + (size_t)row * 512 + (col - 512)) = w; } }
    }
};
struct EpiState {
    static constexpr bool PERM = false;
    float* C;
    __device__ __forceinline__ void operator()(const f32x4 (&acc)[2][2][4][2], const Unit& u, int wr, int wc, int fr, int fq) const {
        float* Cb = C + ((size_t)(u.pn * 512 + u.pm * BM) * 32 + u.pg) * 256;
        const size_t off0 = (size_t)(wr * 64 + fr) * 8192 + (size_t)(wc * 32 + 4 * fq);
#pragma unroll
        for (int ai = 0; ai < 2; ++ai)
#pragma unroll
            for (int m = 0; m < 4; ++m) { float* rowp = Cb + off0 + (size_t)(ai * HALF + m * 16) * 8192;
#pragma unroll
                for (int bj = 0; bj < 2; ++bj)
#pragma unroll
                    for (int n = 0; n < 2; ++n) *(f32x4*)(rowp + bj * HALF + n * 16) = acc[ai][bj][m][n];
                asm volatile("" ::: "memory"); }
    }
};
struct EpiS5 {
    static constexpr bool PERM = true;
    const bf16_t* zs5; const float* dskip; bf16_t* YC;
    __device__ __forceinline__ void operator()(const f32x4 (&acc)[2][2][4][2], const Unit& u, int wr, int wc, int fr, int fq) const {
        const int row0 = u.pm * BM + wr * 64 + fr;
#pragma unroll
        for (int bj = 0; bj < 2; ++bj) { const int n0 = u.pn * BM + bj * HALF + wc * 32 + 8 * fq; const int ch = u.pg * 16 + (n0 & 15);
            const f32x4 d0 = *(const f32x4*)(dskip + ch), d1 = *(const f32x4*)(dskip + ch + 4);
#pragma unroll
            for (int ai = 0; ai < 2; ++ai)
#pragma unroll
                for (int m = 0; m < 4; ++m) { const int R = row0 + ai * HALF + m * 16;
                    const u32x4 uu = *(const u32x4*)(zs5 + ((size_t)(u.pg * 512 + R) * 1280 + n0));
                    const f32x4 v0 = acc[ai][bj][m][0], v1 = acc[ai][bj][m][1];
                    float y[8];
                    y[0] = d0[0] * bf_lo(uu.x) + v0[0]; y[1] = d0[1] * bf_hi(uu.x) + v0[1]; y[2] = d0[2] * bf_lo(uu.y) + v0[2]; y[3] = d0[3] * bf_hi(uu.y) + v0[3];
                    y[4] = d1[0] * bf_lo(uu.z) + v1[0]; y[5] = d1[1] * bf_hi(uu.z) + v1[1]; y[6] = d1[2] * bf_lo(uu.w) + v1[2]; y[7] = d1[3] * bf_hi(uu.w) + v1[3];
#pragma unroll
                    for (int q = 0; q < 8; ++q) y[q] = gelu_tanh(y[q]);
                    u32x4 w; w.x = cvt_pk_bf16(y[0], y[1]); w.y = cvt_pk_bf16(y[2], y[3]); w.z = cvt_pk_bf16(y[4], y[5]); w.w = cvt_pk_bf16(y[6], y[7]);
                    const int tok = R * 64 + (n0 >> 4);
                    *(u32x4*)(YC + (size_t)tok * 1024 + ch) = w; } }
    }
};
struct EpiGluPool {
    static constexpr bool PERM = true;
    const bf16_t* YC; const float* bglu; const float* pscale; bf16_t* MIX;
    __device__ __forceinline__ void operator()(const f32x4 (&acc)[2][2][4][2], const Unit& u, int wr, int wc, int fr, int fq) const {
        const int row0 = u.pm * BM + wr * 64 + fr;
#pragma unroll
        for (int bj = 0; bj < 2; ++bj) { const int col = u.pn * BM + bj * HALF + wc * 32 + 8 * fq;
            const float* vec = (u.pn < 2) ? (bglu + col) : (pscale + (col - 512));
            const f32x4 c0 = *(const f32x4*)vec, c1 = *(const f32x4*)(vec + 4);
#pragma unroll
            for (int ai = 0; ai < 2; ++ai)
#pragma unroll
                for (int m = 0; m < 4; ++m) { const int row = row0 + ai * HALF + m * 16;
                    const f32x4 v0 = acc[ai][bj][m][0], v1 = acc[ai][bj][m][1]; float o[8];
                    if (u.pn < 2) { const u32x4 yy = *(const u32x4*)(YC + (size_t)row * 1024 + col);
                        o[0] = bf_lo(yy.x) * sigmoidf_fast(v0[0] + c0[0]); o[1] = bf_hi(yy.x) * sigmoidf_fast(v0[1] + c0[1]); o[2] = bf_lo(yy.y) * sigmoidf_fast(v0[2] + c0[2]); o[3] = bf_hi(yy.y) * sigmoidf_fast(v0[3] + c0[3]);
                        o[4] = bf_lo(yy.z) * sigmoidf_fast(v1[0] + c1[0]); o[5] = bf_hi(yy.z) * sigmoidf_fast(v1[1] + c1[1]); o[6] = bf_lo(yy.w) * sigmoidf_fast(v1[2] + c1[2]); o[7] = bf_hi(yy.w) * sigmoidf_fast(v1[3] + c1[3]); }
                    else { o[0] = v0[0] * c0[0]; o[1] = v0[1] * c0[1]; o[2] = v0[2] * c0[2]; o[3] = v0[3] * c0[3]; o[4] = v1[0] * c1[0]; o[5] = v1[1] * c1[1]; o[6] = v1[2] * c1[2]; o[7] = v1[3] * c1[3]; }
                    u32x4 w; w.x = cvt_pk_bf16(o[0], o[1]); w.y = cvt_pk_bf16(o[2], o[3]); w.z = cvt_pk_bf16(o[4], o[5]); w.w = cvt_pk_bf16(o[6], o[7]);
                    *(u32x4*)(MIX + (size_t)row * 1024 + col) = w; } }
    }
};
struct EpiRes {
    static constexpr bool PERM = false;
    const float* base; float* out;
    __device__ __forceinline__ void operator()(const f32x4 (&acc)[2][2][4][2], const Unit& u, int wr, int wc, int fr, int fq) const {
        const int row0 = u.pm * BM + wr * 64 + fr, col0 = u.pn * BM + wc * 32 + 4 * fq;
#pragma unroll
        for (int ai = 0; ai < 2; ++ai)
#pragma unroll
            for (int m = 0; m < 4; ++m) { const size_t off = (size_t)(row0 + ai * HALF + m * 16) * 1024 + col0;
#pragma unroll
                for (int bj = 0; bj < 2; ++bj)
#pragma unroll
                    for (int n = 0; n < 2; ++n) { const f32x4 bs = *(const f32x4*)(base + off + bj * HALF + n * 16); *(f32x4*)(out + off + bj * HALF + n * 16) = bs + acc[ai][bj][m][n]; } }
    }
};
struct EpiResB {
    static constexpr bool PERM = true;
    const float* xin; const bf16_t* hin; bf16_t* out;
    __device__ __forceinline__ void operator()(const f32x4 (&acc)[2][2][4][2], const Unit& u, int wr, int wc, int fr, int fq) const {
        const int row0 = u.pm * BM + wr * 64 + fr, col0 = u.pn * BM + wc * 32 + 8 * fq;
#pragma unroll
        for (int ai = 0; ai < 2; ++ai)
#pragma unroll
            for (int m = 0; m < 4; ++m) { const size_t off = (size_t)(row0 + ai * HALF + m * 16) * 1024 + col0;
#pragma unroll
                for (int bj = 0; bj < 2; ++bj) { f32x4 v0 = acc[ai][bj][m][0], v1 = acc[ai][bj][m][1];
                    if (xin) { v0 += *(const f32x4*)(xin + off + bj * HALF); v1 += *(const f32x4*)(xin + off + bj * HALF + 4); }
                    else { const u32x4 w = *(const u32x4*)(hin + off + bj * HALF);
                        v0[0] += bf_lo(w.x); v0[1] += bf_hi(w.x); v0[2] += bf_lo(w.y); v0[3] += bf_hi(w.y); v1[0] += bf_lo(w.z); v1[1] += bf_hi(w.z); v1[2] += bf_lo(w.w); v1[3] += bf_hi(w.w); }
                    u32x4 o; o.x = cvt_pk_bf16(v0[0], v0[1]); o.y = cvt_pk_bf16(v0[2], v0[3]); o.z = cvt_pk_bf16(v1[0], v1[1]); o.w = cvt_pk_bf16(v1[2], v1[3]);
                    *(u32x4*)(out + off + bj * HALF) = o; } }
    }
};
struct EpiSwiglu {
    static constexpr bool PERM = true;
    bf16_t* Hm; const LAS float* rt;
    __device__ __forceinline__ void operator()(const f32x4 (&acc)[2][2][4][2], const Unit& u, int wr, int wc, int fr_, int fq_) const {
        int fr = fr_, fq = fq_; asm volatile("" : "+v"(fr), "+v"(fq));
        const int row0 = u.pm * BM + wr * 64 + fr, col0 = u.pn * HALF + wc * 32 + 8 * fq; const LAS float* rtu = rt + (u.pg & 7) * 256 + wr * 64 + fr;
#pragma unroll
        for (int ai = 0; ai < 2; ++ai)
#pragma unroll
            for (int m = 0; m < 4; ++m) { const float rs = rtu[ai * HALF + m * 16], rsn = rs * -LOG2E, rs2 = rs * rs;
                float p[8], t[8];
#pragma unroll
                for (int q = 0; q < 8; ++q) { const float g = acc[ai][0][m][q >> 2][q & 3], up = acc[ai][1][m][q >> 2][q & 3]; t[q] = g * rsn; p[q] = (g * up) * rs2; }
                __builtin_amdgcn_sched_barrier(0);
#pragma unroll
                for (int q = 0; q < 8; ++q) t[q] = fast_exp2(t[q]);
                __builtin_amdgcn_sched_barrier(0);
#pragma unroll
                for (int q = 0; q < 8; ++q) t[q] = 1.0f + t[q];
                __builtin_amdgcn_sched_barrier(0);
#pragma unroll
                for (int q = 0; q < 8; ++q) t[q] = fast_rcp(t[q]);
                __builtin_amdgcn_sched_barrier(0);
#pragma unroll
                for (int q = 0; q < 8; ++q) p[q] *= t[q];
                __builtin_amdgcn_sched_barrier(0);
                u32x4 w; w.x = cvt_pk_bf16(p[0], p[1]); w.y = cvt_pk_bf16(p[2], p[3]); w.z = cvt_pk_bf16(p[4], p[5]); w.w = cvt_pk_bf16(p[6], p[7]);
                *(u32x4*)(Hm + (size_t)(row0 + ai * HALF + m * 16) * 2048 + col0) = w; }
    }
};
struct EpiGate {
    static constexpr bool PERM = true;
    bf16_t* Y; const float* gate;
    __device__ __forceinline__ void operator()(const f32x4 (&acc)[2][2][4][2], const Unit& u, int wr, int wc, int fr, int fq) const {
        const int row0 = u.pm * BM + wr * 64 + fr, col0 = u.pn * BM + wc * 32 + 8 * fq;
#pragma unroll
        for (int ai = 0; ai < 2; ++ai)
#pragma unroll
            for (int m = 0; m < 4; ++m) { const int row = row0 + ai * HALF + m * 16; const float gt = gate[row];
#pragma unroll
                for (int bj = 0; bj < 2; ++bj) { const f32x4 v0 = acc[ai][bj][m][0] * gt, v1 = acc[ai][bj][m][1] * gt;
                    u32x4 w; w.x = cvt_pk_bf16(v0[0], v0[1]); w.y = cvt_pk_bf16(v0[2], v0[3]); w.z = cvt_pk_bf16(v1[0], v1[1]); w.w = cvt_pk_bf16(v1[2], v1[3]);
                    *(u32x4*)(Y + (size_t)row * 1024 + col0 + bj * HALF) = w; } }
    }
};
}

namespace att {
constexpr int KVBLK = 64, SHM_V = 16384, SHM_K = 16384;
#define KSWZ(row, colB) ((row) * 256 + ((colB) ^ (((row) & 15) << 4)))
#define SBAR() __builtin_amdgcn_sched_barrier(0)
__device__ __forceinline__ int crow(int r, int hi) { return (r & 3) + 8 * (r >> 2) + 4 * hi; }
__device__ __forceinline__ int v_st(int k, int c) { const int kk = (k & ~0xC) | ((k & 4) << 1) | ((k & 8) >> 1); return ((kk >> 3) * 4 + (c >> 5)) * 512 + ((kk & 7) * 32 + (c & 31)) * 2; }
__device__ __forceinline__ int v_rd_base(int lane) { return ((lane & 3) << 3) | (((lane >> 2) & 3) << 6) | (((lane >> 4) & 1) << 5) | (((lane >> 5) & 1) << 8); }
constexpr int v_rd_off(int d0, int ks, int half) { return d0 * 512 + ks * 4096 + half * 2048; }
template <int OFF> __device__ __forceinline__ s16x4 tr_read(int vb) {
    s16x4 r; asm volatile("ds_read_b64_tr_b16 %0, %1 offset:%2" : "=&v"(r) : "v"(vb), "i"(OFF) : "memory"); return r;
}
#define PK4(P, BASE, OUT) do { unsigned a0_ = cvt_pk_bf16(P[BASE + 0], P[BASE + 1]), a1_ = cvt_pk_bf16(P[BASE + 2], P[BASE + 3]);   \
    unsigned b0_ = cvt_pk_bf16(P[BASE + 4], P[BASE + 5]), b1_ = cvt_pk_bf16(P[BASE + 6], P[BASE + 7]);                              \
    auto r0_ = __builtin_amdgcn_permlane32_swap(a0_, b0_, false, false); auto r1_ = __builtin_amdgcn_permlane32_swap(a1_, b1_, false, false); \
    u32x4 w_ = {r0_[0], r1_[0], r0_[1], r1_[1]}; OUT = *reinterpret_cast<bf16x8*>(&w_); } while (0)
__device__ __forceinline__ void qk_pack(f32x16& n0, f32x16& n1, const f32x16& c0, const f32x16& c1, bf16x8& pa0, bf16x8& pa1, bf16x8& pa2, bf16x8& pa3,
                                        const LAS char* Ks, const bf16x8* qr, int r32, int hi, int map) {
    n0 = f32x16{}; n1 = f32x16{};
#pragma unroll
    for (int h = 0; h < 2; ++h) {
        bf16x8 kb[4];
#pragma unroll
        for (int t = 0; t < 2; ++t) { const int cb = (map * 64 + (2 * h + t) * 16 + hi * 8) * 2;
            kb[2 * t] = *(const LAS bf16x8*)(Ks + KSWZ(r32, cb)); kb[2 * t + 1] = *(const LAS bf16x8*)(Ks + KSWZ(32 + r32, cb)); }
        SBAR();
        if (h == 0) { PK4(c0, 0, pa0); PK4(c0, 8, pa1); } else { PK4(c1, 0, pa2); PK4(c1, 8, pa3); }
        SBAR();
        __builtin_amdgcn_s_setprio(1);
#pragma unroll
        for (int t = 0; t < 2; ++t) { n0 = __builtin_amdgcn_mfma_f32_32x32x16_bf16(kb[2 * t], qr[2 * h + t], n0, 0, 0, 0); n1 = __builtin_amdgcn_mfma_f32_32x32x16_bf16(kb[2 * t + 1], qr[2 * h + t], n1, 0, 0, 0); }
        __builtin_amdgcn_s_setprio(0);
        SBAR();
    }
}
template <int D0> __device__ __forceinline__ void pv_exp_one(f32x16& od, int vb, bf16x8 pa0, bf16x8 pa1, bf16x8 pa2, bf16x8 pa3, f32x16& n0, f32x16& n1) {
    const s16x4 l0 = tr_read<v_rd_off(D0, 0, 0)>(vb), h0 = tr_read<v_rd_off(D0, 0, 1)>(vb), l1 = tr_read<v_rd_off(D0, 1, 0)>(vb), h1 = tr_read<v_rd_off(D0, 1, 1)>(vb);
    const s16x4 l2 = tr_read<v_rd_off(D0, 2, 0)>(vb), h2 = tr_read<v_rd_off(D0, 2, 1)>(vb), l3 = tr_read<v_rd_off(D0, 3, 0)>(vb), h3 = tr_read<v_rd_off(D0, 3, 1)>(vb);
    SBAR();
#pragma unroll
    for (int r = 4 * D0; r < 4 * D0 + 4; ++r) { n0[r] = __builtin_amdgcn_exp2f(n0[r]); n1[r] = __builtin_amdgcn_exp2f(n1[r]); }
    SBAR();
    asm volatile("s_waitcnt lgkmcnt(0)" ::: "memory"); SBAR();
#define PK(L, H) (bf16x8){L[0], L[1], L[2], L[3], H[0], H[1], H[2], H[3]}
    __builtin_amdgcn_s_setprio(1);
    od = __builtin_amdgcn_mfma_f32_32x32x16_bf16(pa0, PK(l0, h0), od, 0, 0, 0);
    od = __builtin_amdgcn_mfma_f32_32x32x16_bf16(pa1, PK(l1, h1), od, 0, 0, 0);
    od = __builtin_amdgcn_mfma_f32_32x32x16_bf16(pa2, PK(l2, h2), od, 0, 0, 0);
    od = __builtin_amdgcn_mfma_f32_32x32x16_bf16(pa3, PK(l3, h3), od, 0, 0, 0);
    __builtin_amdgcn_s_setprio(0);
    SBAR();
#undef PK
}
__device__ __forceinline__ void psum(f32x16& osum, bf16x8 pa0, bf16x8 pa1, bf16x8 pa2, bf16x8 pa3) {
    const bf16x8 ones = {0x3F80, 0x3F80, 0x3F80, 0x3F80, 0x3F80, 0x3F80, 0x3F80, 0x3F80};
    osum = __builtin_amdgcn_mfma_f32_32x32x16_bf16(pa0, ones, osum, 0, 0, 0); osum = __builtin_amdgcn_mfma_f32_32x32x16_bf16(pa1, ones, osum, 0, 0, 0);
    osum = __builtin_amdgcn_mfma_f32_32x32x16_bf16(pa2, ones, osum, 0, 0, 0); osum = __builtin_amdgcn_mfma_f32_32x32x16_bf16(pa3, ones, osum, 0, 0, 0);
}
__device__ __forceinline__ void pv_exp(f32x16* o, f32x16& osum, int vb, bf16x8 pa0, bf16x8 pa1, bf16x8 pa2, bf16x8 pa3, f32x16& n0, f32x16& n1) {
    pv_exp_one<0>(o[0], vb, pa0, pa1, pa2, pa3, n0, n1); pv_exp_one<1>(o[1], vb, pa0, pa1, pa2, pa3, n0, n1);
    pv_exp_one<2>(o[2], vb, pa0, pa1, pa2, pa3, n0, n1); pv_exp_one<3>(o[3], vb, pa0, pa1, pa2, pa3, n0, n1);
    psum(osum, pa0, pa1, pa2, pa3); SBAR();
}
template <int D0> __device__ __forceinline__ void pv_one(f32x16& od, int vb, bf16x8 pa0, bf16x8 pa1, bf16x8 pa2, bf16x8 pa3) {
    const s16x4 l0 = tr_read<v_rd_off(D0, 0, 0)>(vb), h0 = tr_read<v_rd_off(D0, 0, 1)>(vb), l1 = tr_read<v_rd_off(D0, 1, 0)>(vb), h1 = tr_read<v_rd_off(D0, 1, 1)>(vb);
    const s16x4 l2 = tr_read<v_rd_off(D0, 2, 0)>(vb), h2 = tr_read<v_rd_off(D0, 2, 1)>(vb), l3 = tr_read<v_rd_off(D0, 3, 0)>(vb), h3 = tr_read<v_rd_off(D0, 3, 1)>(vb);
    asm volatile("s_waitcnt lgkmcnt(0)" ::: "memory"); SBAR();
#define PK(L, H) (bf16x8){L[0], L[1], L[2], L[3], H[0], H[1], H[2], H[3]}
    od = __builtin_amdgcn_mfma_f32_32x32x16_bf16(pa0, PK(l0, h0), od, 0, 0, 0);
    od = __builtin_amdgcn_mfma_f32_32x32x16_bf16(pa1, PK(l1, h1), od, 0, 0, 0);
    od = __builtin_amdgcn_mfma_f32_32x32x16_bf16(pa2, PK(l2, h2), od, 0, 0, 0);
    od = __builtin_amdgcn_mfma_f32_32x32x16_bf16(pa3, PK(l3, h3), od, 0, 0, 0);
#undef PK
}
__device__ __forceinline__ void pv_d0(f32x16* o, int vb, bf16x8 pa0, bf16x8 pa1, bf16x8 pa2, bf16x8 pa3) {
    pv_one<0>(o[0], vb, pa0, pa1, pa2, pa3); pv_one<1>(o[1], vb, pa0, pa1, pa2, pa3); pv_one<2>(o[2], vb, pa0, pa1, pa2, pa3); pv_one<3>(o[3], vb, pa0, pa1, pa2, pa3);
}
__device__ __forceinline__ void qkt(f32x16& p0, f32x16& p1, const LAS char* Ks, const bf16x8* qr, int r32, int hi, int map) {
    p0 = f32x16{}; p1 = f32x16{};
#pragma unroll
    for (int d0 = 0; d0 < 4; ++d0) { const int cb = (map * 64 + d0 * 16 + hi * 8) * 2;
        const bf16x8 b0 = *(const LAS bf16x8*)(Ks + KSWZ(r32, cb));
        const bf16x8 b1 = *(const LAS bf16x8*)(Ks + KSWZ(32 + r32, cb));
        p0 = __builtin_amdgcn_mfma_f32_32x32x16_bf16(b0, qr[d0], p0, 0, 0, 0);
        p1 = __builtin_amdgcn_mfma_f32_32x32x16_bf16(b1, qr[d0], p1, 0, 0, 0); }
}
__device__ __forceinline__ void exp_all(f32x16& p0, f32x16& p1) {
#pragma unroll
    for (int r = 0; r < 16; ++r) { p0[r] = __builtin_amdgcn_exp2f(p0[r]); p1[r] = __builtin_amdgcn_exp2f(p1[r]); }
}
__device__ __forceinline__ void glds16(const void* gsrc, unsigned lds_dst) {
    asm volatile("s_mov_b32 m0, %1\n\ts_nop 0\n\tglobal_load_lds_dwordx4 %0, off" : : "v"(gsrc), "s"(lds_dst) : "memory", "m0"); }
__device__ __forceinline__ void glds16s(unsigned voff, const char* sbase, unsigned lds_dst) {
    asm volatile("s_mov_b32 m0, %2\n\ts_nop 0\n\tglobal_load_lds_dwordx4 %0, %1" : : "v"(voff), "s"(sbase), "s"(lds_dst) : "memory", "m0"); }
__device__ __forceinline__ void glds4(unsigned k0, unsigned k1, unsigned v0, unsigned v1, const char* kbase, const char* vbase, unsigned lds_dst) {
    asm volatile("s_mov_b32 m0, %6\n\ts_nop 0\n\tglobal_load_lds_dwordx4 %0, %4\n\tglobal_load_lds_dwordx4 %1, %4 offset:1024\n\tglobal_load_lds_dwordx4 %2, %5 offset:2048\n\tglobal_load_lds_dwordx4 %3, %5 offset:3072"
                 : : "v"(k0), "v"(k1), "v"(v0), "v"(v1), "s"(kbase), "s"(vbase), "s"(lds_dst) : "memory", "m0"); }
__device__ __forceinline__ void glds_m0(unsigned lds_dst) { asm volatile("s_mov_b32 m0, %0\n\ts_nop 0" : : "s"(lds_dst) : "memory", "m0"); }
template <int OFF> __device__ __forceinline__ void glds_o(unsigned voff, const char* sbase) { asm volatile("global_load_lds_dwordx4 %0, %1 offset:%2" : : "v"(voff), "s"(sbase), "i"(OFF) : "memory"); }
constexpr int SLOTB = 32768, NSLOT = 3;
__device__ __forceinline__ void attn_unit(LAS unsigned char* lds, const bf16_t* __restrict__ Q, const bf16_t* __restrict__ K, const bf16_t* __restrict__ V, bf16_t* __restrict__ O,
                                          int b, int h, int qb, float lam, float osc, const float* __restrict__ subg) {
    int tid_ = threadIdx.x; asm volatile("" : "+v"(tid_));
    const int tid = tid_, wid = __builtin_amdgcn_readfirstlane(tid >> 6), lane = tid & 63, r32 = lane & 31, hi = lane >> 5;
    const int map = wid & 1, rg = wid >> 1;
    const unsigned lds0 = (unsigned)(size_t)lds;
    LAS float* wsf = (LAS float*)(lds + NSLOT * SLOTB) + wid * 64;
    const long rowbase = (long)b * SEQ;
    const bf16_t* Qw = Q + (rowbase + qb * 128 + rg * 32 + r32) * 1024 + h * 128 + map * 64 + hi * 8;
    bf16x8 qr[4];
#pragma unroll
    for (int d0 = 0; d0 < 4; ++d0) qr[d0] = *(const bf16x8*)(Qw + d0 * 16);
    const char* Kt = (const char*)(K + rowbase * 1024 + h * 128); const char* Vt = (const char*)(V + rowbase * 1024 + h * 128);
    unsigned koff[2], voff[2];
#pragma unroll
    for (int i = 0; i < 2; ++i) { const int p = 2 * wid + i;
        const int row = 4 * p + (lane >> 4), chunk = (lane & 15) ^ (row & 15); koff[i] = (unsigned)(row * 2048 + chunk * 16);
        const int kk = (p >> 1) * 8 + ((lane & 31) >> 2), c = (2 * (p & 1) + (lane >> 5)) * 32 + (lane & 3) * 8, k = (kk & ~0xC) | ((kk & 4) << 1) | ((kk & 8) >> 1);
        voff[i] = (unsigned)(k * 2048 + c * 2); }
#define DMA(t, slot) do { const char* kb_ = Kt + (size_t)(t) * (64 * 2048); const char* vb_ = Vt + (size_t)(t) * (64 * 2048); const unsigned sb_ = lds0 + (unsigned)(slot) * SLOTB + (unsigned)wid * 2048u; \
    glds16(kb_ + koff[0], sb_); glds16(kb_ + koff[1], sb_ + 1024u); glds16(vb_ + voff[0], sb_ + 16384u); glds16(vb_ + voff[1], sb_ + 16384u + 1024u); } while (0)
#define WAIT_BAR(N) asm volatile("s_waitcnt vmcnt(" #N ") lgkmcnt(0)\n\ts_barrier" ::: "memory")
    float l_reg = 0.f; f32x16 o[4] = {};
    unsigned kad[4];
#pragma unroll
    for (int d0 = 0; d0 < 4; ++d0) kad[d0] = (unsigned)KSWZ(r32, (map * 64 + d0 * 16 + hi * 8) * 2);
    f32x16 pA0, pA1, pB0, pB1; bf16x8 pa0, pa1, pa2, pa3; constexpr int NT = SEQ / KVBLK;
    const int vrb = (int)lds0 + 16384 + v_rd_base(lane);
    DMA(0, 0); DMA(1, 1);
    WAIT_BAR(4);
    qkt(pA0, pA1, (const LAS char*)lds, qr, r32, hi, map); exp_all(pA0, pA1);
    { float t_ = 0.f;
#pragma unroll
      for (int r = 0; r < 16; ++r) t_ += pA0[r] + pA1[r];
      l_reg += t_; }
    int s_cur = 0, s_nxt = 1, s_nn = 2;
#define KRD(dst, addr, off) asm volatile("ds_read_b128 %0, %1 offset:%2" : "=&v"(dst) : "v"(addr), "i"(off) : "memory")
#define TRD(dst, addr, off) asm volatile("ds_read_b64_tr_b16 %0, %1 offset:%2" : "=&v"(dst) : "v"(addr), "i"(off) : "memory")
#define LWT(n) asm volatile("s_waitcnt lgkmcnt(" #n ")" ::: "memory")
#define PKV(L, H) (bf16x8){L[0], L[1], L[2], L[3], H[0], H[1], H[2], H[3]}
#define DEFERRED() do { \
        o[3] = __builtin_amdgcn_mfma_f32_32x32x16_bf16(pa0, PKV(vc[0], vc[1]), o[3], 0, 0, 0); o[3] = __builtin_amdgcn_mfma_f32_32x32x16_bf16(pa1, PKV(vc[2], vc[3]), o[3], 0, 0, 0); \
        o[3] = __builtin_amdgcn_mfma_f32_32x32x16_bf16(pa2, PKV(vc[4], vc[5]), o[3], 0, 0, 0); o[3] = __builtin_amdgcn_mfma_f32_32x32x16_bf16(pa3, PKV(vc[6], vc[7]), o[3], 0, 0, 0); } while (0)
#define ITER(j, C0, C1, N0, N1, DEFER) do { \
        WAIT_BAR(0);                                                     \
        { const unsigned kb_ = lds0 + (unsigned)s_nxt * SLOTB; const int vb_ = vrb + s_cur * SLOTB; \
          const bool dma_ = (j) + 2 < NT; const char* dk_ = Kt + (size_t)((j) + 2) * (64 * 2048); const char* dv_ = Vt + (size_t)((j) + 2) * (64 * 2048); const unsigned ds_ = lds0 + (unsigned)s_nn * SLOTB + (unsigned)wid * 2048u; \
          bf16x8 kq0, kq1, kq2, kq3; float sA_ = 0.f, sB_ = 0.f; \
          KRD(kq0, kb_ + kad[0], 0); \
          KRD(kq1, kb_ + kad[0], 8192); \
          KRD(kq2, kb_ + kad[1], 0); \
          KRD(kq3, kb_ + kad[1], 8192); \
          SBAR(); \
          if (DEFER) { \
            o[3] = __builtin_amdgcn_mfma_f32_32x32x16_bf16(pa0, PKV(vc[0], vc[1]), o[3], 0, 0, 0); SBAR(); C1[6] = __builtin_amdgcn_exp2f(C1[6]); sA_ += C1[6]; C1[7] = __builtin_amdgcn_exp2f(C1[7]); sB_ += C1[7]; SBAR(); \
            o[3] = __builtin_amdgcn_mfma_f32_32x32x16_bf16(pa1, PKV(vc[2], vc[3]), o[3], 0, 0, 0); SBAR(); C1[8] = __builtin_amdgcn_exp2f(C1[8]); sA_ += C1[8]; C1[9] = __builtin_amdgcn_exp2f(C1[9]); sB_ += C1[9]; SBAR(); \
            o[3] = __builtin_amdgcn_mfma_f32_32x32x16_bf16(pa2, PKV(vc[4], vc[5]), o[3], 0, 0, 0); SBAR(); C1[10] = __builtin_amdgcn_exp2f(C1[10]); sA_ += C1[10]; C1[11] = __builtin_amdgcn_exp2f(C1[11]); sB_ += C1[11]; SBAR(); \
            o[3] = __builtin_amdgcn_mfma_f32_32x32x16_bf16(pa3, PKV(vc[6], vc[7]), o[3], 0, 0, 0); SBAR(); C1[12] = __builtin_amdgcn_exp2f(C1[12]); sA_ += C1[12]; C1[13] = __builtin_amdgcn_exp2f(C1[13]); sB_ += C1[13]; SBAR(); \
          } \
          N0 = f32x16{}; N1 = f32x16{}; \
          LWT(3); SBAR(); N0 = __builtin_amdgcn_mfma_f32_32x32x16_bf16(kq0, qr[0], N0, 0, 0, 0); SBAR(); \
          if (dma_) glds16(dk_ + koff[0], ds_); \
          if (DEFER) { C1[14] = __builtin_amdgcn_exp2f(C1[14]); sA_ += C1[14]; C1[15] = __builtin_amdgcn_exp2f(C1[15]); sB_ += C1[15]; } \
          KRD(kq0, kb_ + kad[2], 0); \
          SBAR(); \
          LWT(3); SBAR(); N1 = __builtin_amdgcn_mfma_f32_32x32x16_bf16(kq1, qr[0], N1, 0, 0, 0); SBAR(); \
          if (dma_) glds16(dk_ + koff[1], ds_ + 1024u); \
          PK4(C0, 0, pa0); \
          KRD(kq1, kb_ + kad[2], 8192); \
          SBAR(); \
          LWT(3); SBAR(); N0 = __builtin_amdgcn_mfma_f32_32x32x16_bf16(kq2, qr[1], N0, 0, 0, 0); SBAR(); \
          if (dma_) glds16(dv_ + voff[0], ds_ + 16384u); \
          PK4(C0, 8, pa1); \
          KRD(kq2, kb_ + kad[3], 0); \
          TRD(va[0], vb_, v_rd_off(0, 0, 0)); TRD(va[1], vb_, v_rd_off(0, 0, 1)); \
          SBAR(); \
          LWT(5); SBAR(); N1 = __builtin_amdgcn_mfma_f32_32x32x16_bf16(kq3, qr[1], N1, 0, 0, 0); SBAR(); \
          if (dma_) glds16(dv_ + voff[1], ds_ + 16384u + 1024u); \
          KRD(kq3, kb_ + kad[3], 8192); \
          TRD(va[2], vb_, v_rd_off(0, 1, 0)); TRD(va[3], vb_, v_rd_off(0, 1, 1)); \
          SBAR(); \
          LWT(7); SBAR(); N0 = __builtin_amdgcn_mfma_f32_32x32x16_bf16(kq0, qr[2], N0, 0, 0, 0); SBAR(); \
          PK4(C1, 0, pa2); \
          TRD(va[4], vb_, v_rd_off(0, 2, 0)); TRD(va[5], vb_, v_rd_off(0, 2, 1)); \
          SBAR(); \
          LWT(8); SBAR(); N1 = __builtin_amdgcn_mfma_f32_32x32x16_bf16(kq1, qr[2], N1, 0, 0, 0); SBAR(); \
          PK4(C1, 8, pa3); \
          TRD(va[6], vb_, v_rd_off(0, 3, 0)); TRD(va[7], vb_, v_rd_off(0, 3, 1)); \
          SBAR(); \
          LWT(9); SBAR(); N0 = __builtin_amdgcn_mfma_f32_32x32x16_bf16(kq2, qr[3], N0, 0, 0, 0); SBAR(); \
          TRD(vc[0], vb_, v_rd_off(1, 0, 0)); TRD(vc[1], vb_, v_rd_off(1, 0, 1)); \
          SBAR(); \
          LWT(8); SBAR(); N1 = __builtin_amdgcn_mfma_f32_32x32x16_bf16(kq3, qr[3], N1, 0, 0, 0); SBAR(); \
          TRD(vc[2], vb_, v_rd_off(1, 1, 0)); TRD(vc[3], vb_, v_rd_off(1, 1, 1)); \
          SBAR(); \
          LWT(11); SBAR(); o[0] = __builtin_amdgcn_mfma_f32_32x32x16_bf16(pa0, PKV(va[0], va[1]), o[0], 0, 0, 0); SBAR(); \
          TRD(vc[4], vb_, v_rd_off(1, 2, 0)); TRD(vc[5], vb_, v_rd_off(1, 2, 1)); \
          SBAR(); \
          LWT(10); SBAR(); o[0] = __builtin_amdgcn_mfma_f32_32x32x16_bf16(pa1, PKV(va[2], va[3]), o[0], 0, 0, 0); SBAR(); \
          TRD(vc[6], vb_, v_rd_off(1, 3, 0)); TRD(vc[7], vb_, v_rd_off(1, 3, 1)); \
          N0[0] = __builtin_amdgcn_exp2f(N0[0]); sA_ += N0[0]; N0[1] = __builtin_amdgcn_exp2f(N0[1]); sB_ += N0[1]; \
          SBAR(); \
          LWT(10); SBAR(); o[0] = __builtin_amdgcn_mfma_f32_32x32x16_bf16(pa2, PKV(va[4], va[5]), o[0], 0, 0, 0); SBAR(); \
          TRD(va[0], vb_, v_rd_off(2, 0, 0)); TRD(va[1], vb_, v_rd_off(2, 0, 1)); \
          N0[2] = __builtin_amdgcn_exp2f(N0[2]); sA_ += N0[2]; N0[3] = __builtin_amdgcn_exp2f(N0[3]); sB_ += N0[3]; \
          SBAR(); \
          LWT(10); SBAR(); o[0] = __builtin_amdgcn_mfma_f32_32x32x16_bf16(pa3, PKV(va[6], va[7]), o[0], 0, 0, 0); SBAR(); \
          TRD(va[2], vb_, v_rd_off(2, 1, 0)); TRD(va[3], vb_, v_rd_off(2, 1, 1)); \
          N0[4] = __builtin_amdgcn_exp2f(N0[4]); sA_ += N0[4]; N0[5] = __builtin_amdgcn_exp2f(N0[5]); sB_ += N0[5]; \
          SBAR(); \
          LWT(10); SBAR(); o[1] = __builtin_amdgcn_mfma_f32_32x32x16_bf16(pa0, PKV(vc[0], vc[1]), o[1], 0, 0, 0); SBAR(); \
          TRD(va[4], vb_, v_rd_off(2, 2, 0)); TRD(va[5], vb_, v_rd_off(2, 2, 1)); \
          N0[6] = __builtin_amdgcn_exp2f(N0[6]); sA_ += N0[6]; N0[7] = __builtin_amdgcn_exp2f(N0[7]); sB_ += N0[7]; \
          SBAR(); \
          LWT(10); SBAR(); o[1] = __builtin_amdgcn_mfma_f32_32x32x16_bf16(pa1, PKV(vc[2], vc[3]), o[1], 0, 0, 0); SBAR(); \
          TRD(va[6], vb_, v_rd_off(2, 3, 0)); TRD(va[7], vb_, v_rd_off(2, 3, 1)); \
          N0[8] = __builtin_amdgcn_exp2f(N0[8]); sA_ += N0[8]; N0[9] = __builtin_amdgcn_exp2f(N0[9]); sB_ += N0[9]; \
          SBAR(); \
          LWT(10); SBAR(); o[1] = __builtin_amdgcn_mfma_f32_32x32x16_bf16(pa2, PKV(vc[4], vc[5]), o[1], 0, 0, 0); SBAR(); \
          TRD(vc[0], vb_, v_rd_off(3, 0, 0)); TRD(vc[1], vb_, v_rd_off(3, 0, 1)); \
          N0[10] = __builtin_amdgcn_exp2f(N0[10]); sA_ += N0[10]; N0[11] = __builtin_amdgcn_exp2f(N0[11]); sB_ += N0[11]; \
          SBAR(); \
          LWT(10); SBAR(); o[1] = __builtin_amdgcn_mfma_f32_32x32x16_bf16(pa3, PKV(vc[6], vc[7]), o[1], 0, 0, 0); SBAR(); \
          TRD(vc[2], vb_, v_rd_off(3, 1, 0)); TRD(vc[3], vb_, v_rd_off(3, 1, 1)); \
          N0[12] = __builtin_amdgcn_exp2f(N0[12]); sA_ += N0[12]; N0[13] = __builtin_amdgcn_exp2f(N0[13]); sB_ += N0[13]; \
          SBAR(); \
          LWT(10); SBAR(); o[2] = __builtin_amdgcn_mfma_f32_32x32x16_bf16(pa0, PKV(va[0], va[1]), o[2], 0, 0, 0); SBAR(); \
          TRD(vc[4], vb_, v_rd_off(3, 2, 0)); TRD(vc[5], vb_, v_rd_off(3, 2, 1)); \
          N0[14] = __builtin_amdgcn_exp2f(N0[14]); sA_ += N0[14]; N0[15] = __builtin_amdgcn_exp2f(N0[15]); sB_ += N0[15]; \
          SBAR(); \
          LWT(10); SBAR(); o[2] = __builtin_amdgcn_mfma_f32_32x32x16_bf16(pa1, PKV(va[2], va[3]), o[2], 0, 0, 0); SBAR(); \
          TRD(vc[6], vb_, v_rd_off(3, 3, 0)); TRD(vc[7], vb_, v_rd_off(3, 3, 1)); \
          N1[0] = __builtin_amdgcn_exp2f(N1[0]); sA_ += N1[0]; N1[1] = __builtin_amdgcn_exp2f(N1[1]); sB_ += N1[1]; \
          SBAR(); \
          LWT(10); SBAR(); o[2] = __builtin_amdgcn_mfma_f32_32x32x16_bf16(pa2, PKV(va[4], va[5]), o[2], 0, 0, 0); SBAR(); \
          N1[2] = __builtin_amdgcn_exp2f(N1[2]); sA_ += N1[2]; N1[3] = __builtin_amdgcn_exp2f(N1[3]); sB_ += N1[3]; \
          SBAR(); \
          LWT(8); SBAR(); o[2] = __builtin_amdgcn_mfma_f32_32x32x16_bf16(pa3, PKV(va[6], va[7]), o[2], 0, 0, 0); SBAR(); \
          N1[4] = __builtin_amdgcn_exp2f(N1[4]); sA_ += N1[4]; N1[5] = __builtin_amdgcn_exp2f(N1[5]); sB_ += N1[5]; \
          SBAR(); \
          l_reg += sA_ + sB_; LWT(0); } \
        { const int t_ = s_cur; s_cur = s_nxt; s_nxt = s_nn; s_nn = t_; } } while (0)
    s16x4 va[8], vc[8];
    if (wid >= 4) __builtin_amdgcn_s_setprio(1);
    ITER(0, pA0, pA1, pB0, pB1, false); ITER(1, pB0, pB1, pA0, pA1, true);
    for (int jj = 2; jj < NT - 2; jj += 2) { ITER(jj, pA0, pA1, pB0, pB1, true); ITER(jj + 1, pB0, pB1, pA0, pA1, true); }
    ITER(NT - 2, pA0, pA1, pB0, pB1, true);
    DEFERRED(); SBAR();
    __builtin_amdgcn_s_setprio(0);
    { float sA_ = 0.f, sB_ = 0.f;
#pragma unroll
      for (int e = 22; e < 32; ++e) { pB1[e - 16] = __builtin_amdgcn_exp2f(pB1[e - 16]); sA_ += pB1[e - 16]; }
      l_reg += sA_ + sB_; }
    PK4(pB0, 0, pa0); PK4(pB0, 8, pa1); PK4(pB1, 0, pa2); PK4(pB1, 8, pa3); SBAR();
    pv_d0(o, vrb + s_cur * SLOTB, pa0, pa1, pa2, pa3);
#undef DEFERRED
#undef ITER
#undef KRD
#undef TRD
#undef LWT
#undef PKV
#undef DMA
    float lt = l_reg; { auto rr = __builtin_amdgcn_permlane32_swap(__float_as_uint(lt), __float_as_uint(lt), false, false); lt = __uint_as_float(rr[0]) + __uint_as_float(rr[1]); }
    if (hi == 0) wsf[r32] = lt;
    asm volatile("s_waitcnt lgkmcnt(0)" ::: "memory");
    const float msc = map ? lam : 1.0f;
#pragma unroll
    for (int r = 0; r < 16; ++r) { const float rl = __builtin_amdgcn_rcpf(wsf[crow(r, hi)]) * msc;
#pragma unroll
        for (int d0 = 0; d0 < 4; ++d0) o[d0][r] *= rl; }
    WAIT_BAR(0);
    LAS float* X = (LAS float*)lds + rg * 4096;
    if (map == 1) {
#pragma unroll
        for (int r = 0; r < 16; ++r)
#pragma unroll
            for (int d0 = 0; d0 < 4; ++d0) X[crow(r, hi) * 128 + 32 * d0 + r32] = o[d0][r];
    }
    WAIT_BAR(0);
    if (map == 0) {
        float sg[4];
#pragma unroll
        for (int d0 = 0; d0 < 4; ++d0) sg[d0] = subg[32 * d0 + r32] * osc;
        bf16_t* Ow = O + (rowbase + qb * 128 + rg * 32) * 1024 + h * 128 + r32;
#pragma unroll
        for (int r = 0; r < 16; ++r) { float ss = 0.f;
#pragma unroll
            for (int d0 = 0; d0 < 4; ++d0) { o[d0][r] -= X[crow(r, hi) * 128 + 32 * d0 + r32]; ss += o[d0][r] * o[d0][r]; }
            ss += __shfl_xor(ss, 1); ss += __shfl_xor(ss, 2); ss += __shfl_xor(ss, 4); ss += __shfl_xor(ss, 8); ss += __shfl_xor(ss, 16);
            const float rs = __builtin_amdgcn_rsqf(ss * (1.0f / 128.0f) + EPS);
#pragma unroll
            for (int d0 = 0; d0 < 4; ++d0) Ow[(long)crow(r, hi) * 1024 + 32 * d0] = (bf16_t)f2bf(o[d0][r] * rs * sg[d0]); }
    }
    WAIT_BAR(0);
#undef WAIT_BAR
}

typedef short v4i16_t __attribute__((ext_vector_type(4)));
#define VTR(p) __builtin_bit_cast(s16x4, __builtin_amdgcn_ds_read_tr16_b64_v4i16((LAS v4i16_t*)(p)))
#define MF16(a, b, c) __builtin_amdgcn_mfma_f32_16x16x32_bf16(a, b, c, 0, 0, 0)
#define PK2(X, Y, OUT) do { u32x4 w_ = {cvt_pk_bf16(X[0], X[1]), cvt_pk_bf16(X[2], X[3]), cvt_pk_bf16(Y[0], Y[1]), cvt_pk_bf16(Y[2], Y[3])}; OUT = *reinterpret_cast<bf16x8*>(&w_); } while (0)
#define KRD(dst, addr, off) asm volatile("ds_read_b128 %0, %1 offset:%2" : "=&v"(dst) : "v"(addr), "i"(off) : "memory")
#define TRD(dst, addr, off) asm volatile("ds_read_b64_tr_b16 %0, %1 offset:%2" : "=&v"(dst) : "v"(addr), "i"(off) : "memory")
#define LWT(n) asm volatile("s_waitcnt lgkmcnt(" #n ")" ::: "memory")
#define PKV(L, H) (bf16x8){L[0], L[1], L[2], L[3], H[0], H[1], H[2], H[3]}
#define FADD(acc, x) ((acc) += (x))
#define WAIT_BAR(N) asm volatile("s_waitcnt vmcnt(" #N ") lgkmcnt(0)\n\ts_barrier" ::: "memory")
#define LBAR() asm volatile("s_waitcnt lgkmcnt(0)\n\ts_barrier" ::: "memory")
__device__ __forceinline__ void attn_unit16(LAS unsigned char* lds, const bf16_t* __restrict__ Q, const bf16_t* __restrict__ K, const bf16_t* __restrict__ V, bf16_t* __restrict__ O,
                                            int b, int h, int qb, float lam, float osc, const float* __restrict__ subg, bf16x8 (&qr)[2][2], bool first, bool has_next, int nb, int nh) {
    int tid_ = threadIdx.x; asm volatile("" : "+v"(tid_));
    const int tid = tid_, wid = __builtin_amdgcn_readfirstlane(tid >> 6), lane = tid & 63, t16 = lane & 15, rq = lane >> 4;
    const int map = wid & 1, rg = wid >> 1;
    const unsigned lds0 = (unsigned)(size_t)lds;
    LAS float* wsf = (LAS float*)(lds + NSLOT * SLOTB) + wid * 64;
    const long rowbase = (long)b * SEQ;
    if (first) {
#pragma unroll
        for (int hh = 0; hh < 2; ++hh)
#pragma unroll
            for (int ds = 0; ds < 2; ++ds) qr[hh][ds] = *(const bf16x8*)(Q + (rowbase + qb * 128 + rg * 32 + 16 * hh + t16) * 1024 + h * 128 + map * 64 + 32 * ds + 8 * rq); }
    const char* Kt = (const char*)(K + rowbase * 1024 + h * 128); const char* Vt = (const char*)(V + rowbase * 1024 + h * 128);
    unsigned koff[2], voff[2];
#pragma unroll
    for (int i = 0; i < 2; ++i) { const int p = 2 * wid + i;
        const int row = 4 * p + (lane >> 4), chunk = (lane & 15) ^ (row & 15); koff[i] = (unsigned)(row * 2048 + chunk * 16) - (i ? 1024u : 0u);
        const int key = 16 * (p & 3) + (lane >> 2), c = lane & 3, col = (p >> 2) * 32 + (((c >> 1) ^ ((key >> 2) & 1)) * 16) + (c & 1) * 8;
        voff[i] = (unsigned)(key * 2048 + col * 2) + (i ? 0u : 1024u); }
#define DMA(t, slot) DMAX(Kt, Vt, t, slot)
#define DMAX(KT_, VT_, t, slot) do { const char* kb_ = (KT_) + (size_t)(t) * (64 * 2048); const char* vb_ = (VT_) + (size_t)(t) * (64 * 2048); const unsigned sb_ = lds0 + (unsigned)(slot) * SLOTB + (unsigned)wid * 4096u; \
    glds4(koff[0], koff[1], voff[0], voff[1], kb_, vb_ - 3072, sb_); } while (0)
    unsigned kad[2];
#pragma unroll
    for (int ds = 0; ds < 2; ++ds) kad[ds] = (unsigned)((t16 >> 3) * 4096 + ((t16 >> 2) & 1) * 1024 + (t16 & 3) * 256 + ((map * 128 + ds * 64 + rq * 16) ^ (t16 << 4)));
    const unsigned vbe = (unsigned)((4 * rq + (t16 >> 2)) * 64 + (t16 & 3) * 8 + (rq & 1) * 32), vbo = (unsigned)((4 * rq + (t16 >> 2)) * 64 + (t16 & 3) * 8 + ((rq & 1) ^ 1) * 32);
    f32x4 ls0 = {0.f, 0.f, 0.f, 0.f}, ls1 = {0.f, 0.f, 0.f, 0.f}; f32x4 o[2][8];
    bf16x8 ones_ = {0x3F80, 0x3F80, 0x3F80, 0x3F80, 0x3F80, 0x3F80, 0x3F80, 0x3F80}; asm volatile("" : "+v"(ones_));
#pragma unroll
    for (int hh = 0; hh < 2; ++hh)
#pragma unroll
        for (int cb = 0; cb < 8; ++cb) o[hh][cb] = (f32x4){0.f, 0.f, 0.f, 0.f};
    f32x4 pA[2][4], pB[2][4]; bf16x8 pa00, pa01, pa10, pa11; s16x4 vf[8][2]; constexpr int NT = SEQ / KVBLK;
    const f32x4 z4_ = {0.f, 0.f, 0.f, 0.f};
    if (first) { DMA(0, 0); DMA(1, 1); }
    WAIT_BAR(0);
    {
#pragma unroll
        for (int kb = 0; kb < 4; ++kb) { const bf16x8 k0 = *(const LAS bf16x8*)(lds + kad[0] + kb * 8192), k1 = *(const LAS bf16x8*)(lds + kad[1] + kb * 8192);
#pragma unroll
            for (int hh = 0; hh < 2; ++hh) { f32x4 sacc = MF16(k0, qr[hh][0], z4_); sacc = MF16(k1, qr[hh][1], sacc);
#pragma unroll
                for (int r = 0; r < 4; ++r) { sacc[r] = __builtin_amdgcn_exp2f(sacc[r]); }
                pA[hh][kb] = sacc; } }
    }
    asm volatile("s_nop 1" ::: "memory"); PK2(pA[0][0], pA[0][1], pa00); PK2(pA[1][0], pA[1][1], pa10);
    __builtin_amdgcn_s_setprio(1);
#define ITER(j, C, N, SC, SN, SNN, DMA_) do { \
        WAIT_BAR(0); \
        { const LAS unsigned char* kp_ = lds + (SN) * SLOTB; const LAS unsigned char* ve_ = lds + ((SC) * SLOTB + 2048) + vbe; const LAS unsigned char* vo_ = lds + ((SC) * SLOTB + 2048) + vbo; \
          constexpr bool dma_ = DMA_; const char* dk_ = Kt + (size_t)((j) + 2) * (64 * 2048); const char* dv_ = Vt + (size_t)((j) + 2) * (64 * 2048); const unsigned ds_ = lds0 + (unsigned)(SNN) * SLOTB + (unsigned)wid * 4096u; \
          bf16x8 kq0, kq1, kq2, kq3, kq4, kq5, kq6, kq7; \
          kq0 = *(const LAS bf16x8*)(kp_ + kad[0] + 0); \
          kq1 = *(const LAS bf16x8*)(kp_ + kad[1] + 0); \
          kq2 = *(const LAS bf16x8*)(kp_ + kad[0] + 8192); \
          kq3 = *(const LAS bf16x8*)(kp_ + kad[1] + 8192); \
          SBAR(); \
          SBAR(); N[0][0] = MF16(kq0, qr[0][0], z4_); N[1][0] = MF16(kq0, qr[1][0], z4_); SBAR(); \
          if constexpr (dma_) { glds_m0(ds_); glds_o<0>(koff[0], dk_); } \
          kq4 = *(const LAS bf16x8*)(kp_ + kad[0] + 16384); \
          SBAR(); \
          SBAR(); N[0][0] = MF16(kq1, qr[0][1], N[0][0]); N[1][0] = MF16(kq1, qr[1][1], N[1][0]); SBAR(); \
          if constexpr (dma_) glds_o<1024>(koff[1], dk_); \
          kq5 = *(const LAS bf16x8*)(kp_ + kad[1] + 16384); \
          SBAR(); \
          SBAR(); N[0][1] = MF16(kq2, qr[0][0], z4_); N[1][1] = MF16(kq2, qr[1][0], z4_); SBAR(); \
          if constexpr (dma_) glds_o<2048>(voff[0], dv_ - 3072); \
          kq6 = *(const LAS bf16x8*)(kp_ + kad[0] + 24576); \
          SBAR(); \
          SBAR(); N[0][1] = MF16(kq3, qr[0][1], N[0][1]); N[1][1] = MF16(kq3, qr[1][1], N[1][1]); SBAR(); \
          if constexpr (dma_) glds_o<3072>(voff[1], dv_ - 3072); \
          kq7 = *(const LAS bf16x8*)(kp_ + kad[1] + 24576); \
          SBAR(); \
          SBAR(); N[0][2] = MF16(kq4, qr[0][0], z4_); N[1][2] = MF16(kq4, qr[1][0], z4_); SBAR(); \
          PK2(C[0][2], C[0][3], pa01); \
          vf[0][0] = VTR(ve_ + 0); vf[0][1] = VTR(ve_ + 1024); \
          SBAR(); \
          SBAR(); N[0][2] = MF16(kq5, qr[0][1], N[0][2]); N[1][2] = MF16(kq5, qr[1][1], N[1][2]); SBAR(); \
          PK2(C[1][2], C[1][3], pa11); \
          vf[1][0] = VTR(vo_ + 0); vf[1][1] = VTR(vo_ + 1024); \
          SBAR(); \
          SBAR(); N[0][3] = MF16(kq6, qr[0][0], z4_); N[1][3] = MF16(kq6, qr[1][0], z4_); SBAR(); \
          vf[2][0] = VTR(ve_ + 8192); vf[2][1] = VTR(ve_ + 9216); \
          SBAR(); \
          SBAR(); N[0][3] = MF16(kq7, qr[0][1], N[0][3]); N[1][3] = MF16(kq7, qr[1][1], N[1][3]); SBAR(); \
          vf[3][0] = VTR(vo_ + 8192); vf[3][1] = VTR(vo_ + 9216); \
          SBAR(); \
          SBAR(); o[0][0] = MF16(pa00, PKV(vf[0][0], vf[0][1]), o[0][0]); o[1][0] = MF16(pa10, PKV(vf[0][0], vf[0][1]), o[1][0]); SBAR(); \
          vf[4][0] = VTR(ve_ + 16384); vf[4][1] = VTR(ve_ + 17408); \
          SBAR(); \
          SBAR(); o[0][1] = MF16(pa00, PKV(vf[1][0], vf[1][1]), o[0][1]); o[1][1] = MF16(pa10, PKV(vf[1][0], vf[1][1]), o[1][1]); SBAR(); \
          vf[5][0] = VTR(vo_ + 16384); vf[5][1] = VTR(vo_ + 17408); \
          SBAR(); \
          SBAR(); o[0][2] = MF16(pa00, PKV(vf[2][0], vf[2][1]), o[0][2]); o[1][2] = MF16(pa10, PKV(vf[2][0], vf[2][1]), o[1][2]); SBAR(); \
          vf[6][0] = VTR(ve_ + 24576); vf[6][1] = VTR(ve_ + 25600); \
          SBAR(); \
          SBAR(); o[0][3] = MF16(pa00, PKV(vf[3][0], vf[3][1]), o[0][3]); o[1][3] = MF16(pa10, PKV(vf[3][0], vf[3][1]), o[1][3]); SBAR(); \
          vf[7][0] = VTR(vo_ + 24576); vf[7][1] = VTR(vo_ + 25600); \
          SBAR(); \
          SBAR(); o[0][4] = MF16(pa00, PKV(vf[4][0], vf[4][1]), o[0][4]); o[1][4] = MF16(pa10, PKV(vf[4][0], vf[4][1]), o[1][4]); SBAR(); \
          vf[0][0] = VTR(ve_ + 4096); vf[0][1] = VTR(ve_ + 5120); \
          SBAR(); \
          SBAR(); o[0][5] = MF16(pa00, PKV(vf[5][0], vf[5][1]), o[0][5]); o[1][5] = MF16(pa10, PKV(vf[5][0], vf[5][1]), o[1][5]); SBAR(); \
          vf[1][0] = VTR(vo_ + 4096); vf[1][1] = VTR(vo_ + 5120); \
          SBAR(); \
          SBAR(); o[0][6] = MF16(pa00, PKV(vf[6][0], vf[6][1]), o[0][6]); o[1][6] = MF16(pa10, PKV(vf[6][0], vf[6][1]), o[1][6]); SBAR(); \
          vf[2][0] = VTR(ve_ + 12288); vf[2][1] = VTR(ve_ + 13312); \
          SBAR(); \
          SBAR(); o[0][7] = MF16(pa00, PKV(vf[7][0], vf[7][1]), o[0][7]); o[1][7] = MF16(pa10, PKV(vf[7][0], vf[7][1]), o[1][7]); ls0 = MF16(pa00, ones_, ls0); ls1 = MF16(pa10, ones_, ls1); SBAR(); \
          vf[3][0] = VTR(vo_ + 12288); vf[3][1] = VTR(vo_ + 13312); \
          SBAR(); \
          SBAR(); __builtin_amdgcn_s_setprio(0); \
          N[0][0][0] = __builtin_amdgcn_exp2f(N[0][0][0]); N[0][0][1] = __builtin_amdgcn_exp2f(N[0][0][1]); N[0][0][2] = __builtin_amdgcn_exp2f(N[0][0][2]); N[0][0][3] = __builtin_amdgcn_exp2f(N[0][0][3]); \
          N[0][1][0] = __builtin_amdgcn_exp2f(N[0][1][0]); N[0][1][1] = __builtin_amdgcn_exp2f(N[0][1][1]); N[0][1][2] = __builtin_amdgcn_exp2f(N[0][1][2]); N[0][1][3] = __builtin_amdgcn_exp2f(N[0][1][3]); \
          N[1][0][0] = __builtin_amdgcn_exp2f(N[1][0][0]); N[1][0][1] = __builtin_amdgcn_exp2f(N[1][0][1]); N[1][0][2] = __builtin_amdgcn_exp2f(N[1][0][2]); N[1][0][3] = __builtin_amdgcn_exp2f(N[1][0][3]); \
          N[1][1][0] = __builtin_amdgcn_exp2f(N[1][1][0]); N[1][1][1] = __builtin_amdgcn_exp2f(N[1][1][1]); N[1][1][2] = __builtin_amdgcn_exp2f(N[1][1][2]); N[1][1][3] = __builtin_amdgcn_exp2f(N[1][1][3]); \
          SBAR(); \
          N[0][2][0] = __builtin_amdgcn_exp2f(N[0][2][0]); N[0][2][1] = __builtin_amdgcn_exp2f(N[0][2][1]); N[0][2][2] = __builtin_amdgcn_exp2f(N[0][2][2]); N[0][2][3] = __builtin_amdgcn_exp2f(N[0][2][3]); \
          N[0][3][0] = __builtin_amdgcn_exp2f(N[0][3][0]); N[0][3][1] = __builtin_amdgcn_exp2f(N[0][3][1]); N[0][3][2] = __builtin_amdgcn_exp2f(N[0][3][2]); N[0][3][3] = __builtin_amdgcn_exp2f(N[0][3][3]); \
          N[1][2][0] = __builtin_amdgcn_exp2f(N[1][2][0]); N[1][2][1] = __builtin_amdgcn_exp2f(N[1][2][1]); N[1][2][2] = __builtin_amdgcn_exp2f(N[1][2][2]); N[1][2][3] = __builtin_amdgcn_exp2f(N[1][2][3]); \
          N[1][3][0] = __builtin_amdgcn_exp2f(N[1][3][0]); N[1][3][1] = __builtin_amdgcn_exp2f(N[1][3][1]); N[1][3][2] = __builtin_amdgcn_exp2f(N[1][3][2]); N[1][3][3] = __builtin_amdgcn_exp2f(N[1][3][3]); \
          SBAR(); \
          PK2(N[0][0], N[0][1], pa00); PK2(N[1][0], N[1][1], pa10); \
          __builtin_amdgcn_s_setprio(1); SBAR(); \
          SBAR(); o[0][0] = MF16(pa01, PKV(vf[0][0], vf[0][1]), o[0][0]); o[1][0] = MF16(pa11, PKV(vf[0][0], vf[0][1]), o[1][0]); SBAR(); \
          vf[4][0] = VTR(ve_ + 20480); vf[4][1] = VTR(ve_ + 21504); \
          SBAR(); \
          SBAR(); o[0][1] = MF16(pa01, PKV(vf[1][0], vf[1][1]), o[0][1]); o[1][1] = MF16(pa11, PKV(vf[1][0], vf[1][1]), o[1][1]); SBAR(); \
          vf[5][0] = VTR(vo_ + 20480); vf[5][1] = VTR(vo_ + 21504); \
          SBAR(); \
          SBAR(); o[0][2] = MF16(pa01, PKV(vf[2][0], vf[2][1]), o[0][2]); o[1][2] = MF16(pa11, PKV(vf[2][0], vf[2][1]), o[1][2]); SBAR(); \
          vf[6][0] = VTR(ve_ + 28672); vf[6][1] = VTR(ve_ + 29696); \
          SBAR(); \
          SBAR(); o[0][3] = MF16(pa01, PKV(vf[3][0], vf[3][1]), o[0][3]); o[1][3] = MF16(pa11, PKV(vf[3][0], vf[3][1]), o[1][3]); SBAR(); \
          vf[7][0] = VTR(vo_ + 28672); vf[7][1] = VTR(vo_ + 29696); \
          SBAR(); \
          SBAR(); o[0][4] = MF16(pa01, PKV(vf[4][0], vf[4][1]), o[0][4]); o[1][4] = MF16(pa11, PKV(vf[4][0], vf[4][1]), o[1][4]); SBAR(); \
          SBAR(); \
          SBAR(); o[0][5] = MF16(pa01, PKV(vf[5][0], vf[5][1]), o[0][5]); o[1][5] = MF16(pa11, PKV(vf[5][0], vf[5][1]), o[1][5]); SBAR(); \
          SBAR(); \
          SBAR(); o[0][6] = MF16(pa01, PKV(vf[6][0], vf[6][1]), o[0][6]); o[1][6] = MF16(pa11, PKV(vf[6][0], vf[6][1]), o[1][6]); SBAR(); \
          SBAR(); \
          SBAR(); o[0][7] = MF16(pa01, PKV(vf[7][0], vf[7][1]), o[0][7]); o[1][7] = MF16(pa11, PKV(vf[7][0], vf[7][1]), o[1][7]); ls0 = MF16(pa01, ones_, ls0); ls1 = MF16(pa11, ones_, ls1); SBAR(); \
          SBAR(); \
          } \
        } while (0)
    static_assert((NT - 1) % 6 == 3 && (NT - 1) % 3 == 0, "tile count");
    for (int jj = 0; jj < NT - 4; jj += 6) {
        ITER(jj, pA, pB, 0, 1, 2, true); ITER(jj + 1, pB, pA, 1, 2, 0, true); ITER(jj + 2, pA, pB, 2, 0, 1, true);
        ITER(jj + 3, pB, pA, 0, 1, 2, true); ITER(jj + 4, pA, pB, 1, 2, 0, true); ITER(jj + 5, pB, pA, 2, 0, 1, true); }
    ITER(NT - 4, pA, pB, 0, 1, 2, true); ITER(NT - 3, pB, pA, 1, 2, 0, true); ITER(NT - 2, pA, pB, 2, 0, 1, false);
    SBAR();
    PK2(pB[0][0], pB[0][1], pa00); PK2(pB[0][2], pB[0][3], pa01); PK2(pB[1][0], pB[1][1], pa10); PK2(pB[1][2], pB[1][3], pa11); SBAR();
    ls0 = MF16(pa00, ones_, ls0); ls1 = MF16(pa10, ones_, ls1); ls0 = MF16(pa01, ones_, ls0); ls1 = MF16(pa11, ones_, ls1);
    { const unsigned vb_ = lds0 + (unsigned)((NT - 1) % 3) * SLOTB + 2048u;
#pragma unroll
      for (int kg = 0; kg < 2; ++kg)
#pragma unroll
          for (int cb = 0; cb < 8; ++cb) { s16x4 f0, f1; const unsigned ad = vb_ + ((cb & 1) ? vbo : vbe) + (unsigned)(kg * 4096 + (cb >> 1) * 8192);
              asm volatile("ds_read_b64_tr_b16 %0, %1" : "=&v"(f0) : "v"(ad) : "memory"); asm volatile("ds_read_b64_tr_b16 %0, %1 offset:1024" : "=&v"(f1) : "v"(ad) : "memory");
              LWT(0); SBAR();
              o[0][cb] = MF16(kg ? pa01 : pa00, PKV(f0, f1), o[0][cb]); o[1][cb] = MF16(kg ? pa11 : pa10, PKV(f0, f1), o[1][cb]); SBAR(); } }
#undef ITER
    __builtin_amdgcn_s_setprio(0);
    const float msc = map ? lam : 1.0f;
#pragma unroll
    for (int hh = 0; hh < 2; ++hh)
#pragma unroll
        for (int r = 0; r < 4; ++r) { const float rl = __builtin_amdgcn_rcpf(hh ? ls1[r] : ls0[r]) * msc;
#pragma unroll
            for (int cb = 0; cb < 8; ++cb) o[hh][cb][r] *= rl; }
    WAIT_BAR(0);
    if (has_next) {
        const long rbn = (long)nb * SEQ;
#pragma unroll
        for (int hh = 0; hh < 2; ++hh)
#pragma unroll
            for (int ds = 0; ds < 2; ++ds) qr[hh][ds] = *(const bf16x8*)(Q + (rbn + qb * 128 + rg * 32 + 16 * hh + t16) * 1024 + nh * 128 + map * 64 + 32 * ds + 8 * rq);
        const char* Ktn = (const char*)(K + rbn * 1024 + nh * 128); const char* Vtn = (const char*)(V + rbn * 1024 + nh * 128);
        DMAX(Ktn, Vtn, 0, 0); DMAX(Ktn, Vtn, 1, 1); }
    LAS float* X = (LAS float*)(lds + (rg == 0 ? 98304 : rg == 1 ? 114688 : rg == 2 ? 133120 : 65536));
    if (map == 1) {
#pragma unroll
        for (int hh = 0; hh < 2; ++hh)
#pragma unroll
            for (int r = 0; r < 4; ++r)
#pragma unroll
                for (int cb = 0; cb < 8; ++cb) X[(16 * hh + 4 * rq + r) * 128 + 16 * cb + t16] = o[hh][cb][r];
    }
    LBAR();
    if (map == 0) {
        float sg[8];
#pragma unroll
        for (int cb = 0; cb < 8; ++cb) sg[cb] = subg[16 * cb + t16] * osc;
        bf16_t* Ow = O + (rowbase + qb * 128 + rg * 32) * 1024 + h * 128 + t16;
#pragma unroll
        for (int hh = 0; hh < 2; ++hh)
#pragma unroll
            for (int r = 0; r < 4; ++r) { const int q = 16 * hh + 4 * rq + r; float ss = 0.f;
#pragma unroll
                for (int cb = 0; cb < 8; ++cb) { o[hh][cb][r] -= X[q * 128 + 16 * cb + t16]; ss += o[hh][cb][r] * o[hh][cb][r]; }
                ss += __shfl_xor(ss, 1); ss += __shfl_xor(ss, 2); ss += __shfl_xor(ss, 4); ss += __shfl_xor(ss, 8);
                const float rs = __builtin_amdgcn_rsqf(ss * (1.0f / 128.0f) + EPS);
#pragma unroll
                for (int cb = 0; cb < 8; ++cb) Ow[(long)q * 1024 + 16 * cb] = (bf16_t)f2bf(o[hh][cb][r] * rs * sg[cb]); }
    }
#undef DMA
#undef DMAX
}
#undef MF16
#undef PK2
#undef KRD
#undef TRD
#undef LWT
#undef PKV
#undef FADD
#undef WAIT_BAR
#undef KSWZ
#undef SBAR
}

constexpr int MOE_PREP_SEL_PER_WAVE = 3;
constexpr int MOE_PREP_HEAD = 16 * 1536 - MOE_PREP_SEL_PER_WAVE * 224 * 8;
struct Params { const void* in[31]; float* out; unsigned char* ws; };
struct Ctx { LAS unsigned char* lds; int tid, lane, wave, vcu, G, gw, NGW; };

template <class RM>
__device__ __forceinline__ void transpose_item(const float* W, int N, bf16_t* WT, int ldt, RM rm, LAS float* scr, int item, int lane) {
    const int nblk = N / 32, kb = item / nblk, nb = item % nblk, k0 = 64 * kb, n0 = 32 * nb;
    f32x4 v[8];
#pragma unroll
    for (int i = 0; i < 8; ++i) v[i] = __builtin_nontemporal_load((const f32x4*)(W + (size_t)(k0 + 8 * i + (lane >> 3)) * N + n0 + 4 * (lane & 7)));
#pragma unroll
    for (int i = 0; i < 8; ++i) { LAS float* d = scr + (8 * i + (lane >> 3)) * 33 + 4 * (lane & 7); d[0] = v[i][0]; d[1] = v[i][1]; d[2] = v[i][2]; d[3] = v[i][3]; }
    LDS_WAIT(); asm volatile("" ::: "memory");
    const int c = lane & 7;
#pragma unroll
    for (int j = 0; j < 4; ++j) { const int n = (lane >> 3) + 8 * j; const LAS float* s = scr + (8 * c) * 33 + n;
        u32x4 o; o.x = cvt_pk_bf16(s[0 * 33], s[1 * 33]); o.y = cvt_pk_bf16(s[2 * 33], s[3 * 33]); o.z = cvt_pk_bf16(s[4 * 33], s[5 * 33]); o.w = cvt_pk_bf16(s[6 * 33], s[7 * 33]);
        *(u32x4*)(WT + (size_t)rm(n0 + n) * ldt + k0 + 8 * c) = o; }
    LDS_WAIT(); asm volatile("" ::: "memory");
}
template <class RM>
__device__ __forceinline__ void transpose_item64(const float* W, int N, bf16_t* WT, int ldt, RM rm, LAS float* scr, int item, int lane, const float* gk = nullptr) {
    const int nblk = N / 64, kb = item / nblk, nb = item % nblk, k0 = 64 * kb, n0 = 64 * nb;
    f32x4 v[16];
#pragma unroll
    for (int i = 0; i < 16; ++i) v[i] = __builtin_nontemporal_load((const f32x4*)(W + (size_t)(k0 + 4 * i + (lane >> 4)) * N + n0 + 4 * (lane & 15)));
    if (gk) {
#pragma unroll
        for (int i = 0; i < 16; ++i) v[i] *= gk[k0 + 4 * i + (lane >> 4)]; }
#pragma unroll
    for (int i = 0; i < 16; ++i) { const int kk = 4 * i + (lane >> 4), c4 = 4 * (lane & 15); *(LAS f32x4*)(scr + kk * 64 + (c4 ^ (((kk >> 3) & 7) << 3))) = v[i]; }
    LDS_WAIT(); asm volatile("" ::: "memory");
    const int cb = lane & 7;
#pragma unroll
    for (int j = 0; j < 8; ++j) { const int n = (lane >> 3) + 8 * j; const LAS float* s = scr + (8 * cb) * 64 + (n ^ (cb << 3));
        u32x4 o; o.x = cvt_pk_bf16(s[0 * 64], s[1 * 64]); o.y = cvt_pk_bf16(s[2 * 64], s[3 * 64]); o.z = cvt_pk_bf16(s[4 * 64], s[5 * 64]); o.w = cvt_pk_bf16(s[6 * 64], s[7 * 64]);
        *(u32x4*)(WT + (size_t)rm(n0 + n) * ldt + k0 + 8 * cb) = o; }
    LDS_WAIT(); asm volatile("" ::: "memory");
}
struct RmId { __device__ __forceinline__ int operator()(int n) const { return n; } };
struct RmQK { __device__ __forceinline__ int operator()(int n) const { const int i = n & 63; return n < 2048 ? ((n & ~63) + (i < 32 ? 2 * i : 2 * (i - 32) + 1)) : n; } };
struct RmGate { int add; __device__ __forceinline__ int operator()(int n) const { return ((n >> 7) << 8) + add + (n & 127); } };

__device__ __forceinline__ void rms_row_to_bf16(const float* xrow, const f32x4 (&g4)[4], bf16_t* orow, int lane) {
    const f32x4* xr = (const f32x4*)xrow + lane; f32x4 v[4]; float s = 0.f;
#pragma unroll
    for (int j = 0; j < 4; ++j) { v[j] = xr[64 * j]; s += (v[j][0] * v[j][0] + v[j][1] * v[j][1]) + (v[j][2] * v[j][2] + v[j][3] * v[j][3]); }
    const float rstd = __builtin_amdgcn_rsqf(wave_sum(s) * (1.f / DM) + EPS);
    u32x2* o8 = (u32x2*)orow + lane;
#pragma unroll
    for (int j = 0; j < 4; ++j) { const f32x4 y = v[j] * rstd * g4[j]; u32x2 w; w.x = cvt_pk_bf16(y[0], y[1]); w.y = cvt_pk_bf16(y[2], y[3]); o8[64 * j] = w; }
}

__device__ __forceinline__ void moe_weight_prep(const Ctx& F, const float* wg, const float* wu, const float* wd, const float* gain, bf16_t* bt1, bf16_t* bt2, int w0, int nw, int iend = 16 * 1536) {
    LAS float* scr = (LAS float*)(F.lds + F.wave * 16384);
    for (int it = w0; it < iend; it += nw) {
        const int e = it / 1536, r = it % 1536;
        if (r < 512) transpose_item64(wg + (size_t)e * 1024 * 2048, 2048, bt1 + (size_t)e * 4096 * 1024, 1024, RmGate{0}, scr, r, F.lane, gain);
        else if (r < 1024) transpose_item64(wu + (size_t)e * 1024 * 2048, 2048, bt1 + (size_t)e * 4096 * 1024, 1024, RmGate{128}, scr, r - 512, F.lane, gain);
        else transpose_item64(wd + (size_t)e * 2048 * 1024, 1024, bt2 + (size_t)e * 1024 * 2048, 2048, RmId{}, scr, r - 1024, F.lane);
    }
}
template <class RM = RmId>
__device__ __forceinline__ void weight_prep(const Ctx& F, const float* W, int K, int N, bf16_t* WT, int w0, int nw) {
    LAS float* scr = (LAS float*)(F.lds + F.wave * 16384);
    const int items = (K / 64) * (N / 32);
    for (int it = w0; it < items; it += nw) transpose_item(W, N, WT, K, RM{}, scr, it, F.lane);
}

__device__ __forceinline__ void s5_prep1(const Ctx& F, const unsigned char* lds_raw, int ev, bf16_t* wst, bf16_t* btm, float* kbuf, float* aL) {
    const float* lam_re = (const float*)getp(lds_raw, 6) + (size_t)ev * 2 * 32 * 64; const float* lam_im = (const float*)getp(lds_raw, 7) + (size_t)ev * 2 * 32 * 64;
    const float* log_dt = (const float*)getp(lds_raw, 8) + (size_t)ev * 2 * 32;
    const float* b_re = (const float*)getp(lds_raw, 9) + (size_t)ev * 2 * 32 * 64 * 16; const float* b_im = (const float*)getp(lds_raw, 10) + (size_t)ev * 2 * 32 * 64 * 16;
    const float* c_re = (const float*)getp(lds_raw, 11) + (size_t)ev * 2 * 32 * 16 * 64; const float* c_im = (const float*)getp(lds_raw, 12) + (size_t)ev * 2 * 32 * 16 * 64;
    LAS float* AP = (LAS float*)F.lds; LAS float* BB = (LAS float*)(F.lds + 66560); LAS float* CC = (LAS float*)(F.lds + 82944);
    for (int g = F.vcu; g < 32; g += F.G) {
        __syncthreads();
        if (F.tid < 128) { const int dir = F.tid >> 6, p = F.tid & 63; const int pi = (dir * 32 + g) * 64 + p;
            const float lre = lam_re[pi], lim = lam_im[pi]; const float dt = __expf(log_dt[dir * 32 + g]);
            for (int tau = 0; tau <= 64; ++tau) { const float mag = __expf((float)tau * lre * dt); float s, c; sincos_big((double)tau * (double)lim * (double)dt, s, c);
                AP[((dir * 65 + tau) * 64 + p) * 2] = mag * c; AP[((dir * 65 + tau) * 64 + p) * 2 + 1] = mag * s; }
            float a_re, a_im; { const float mag = __expf(lre * dt); float s, c; sincos_big((double)lim * (double)dt, s, c); a_re = mag * c; a_im = mag * s; }
            const float nr = a_re - 1.0f, ni = a_im, den = 1.0f / (lre * lre + lim * lim);
            const float cr = (nr * lre + ni * lim) * den, ci = (ni * lre - nr * lim) * den;
            for (int c = 0; c < 16; ++c) { const float br = b_re[(size_t)pi * 16 + c], bi = b_im[(size_t)pi * 16 + c];
                BB[((dir * 64 + p) * 16 + c) * 2] = cr * br - ci * bi; BB[((dir * 64 + p) * 16 + c) * 2 + 1] = cr * bi + ci * br; }
        }
        for (int i = F.tid; i < 2048; i += NTHR) { const int dir = i >> 10, c = (i >> 6) & 15, p = i & 63; const size_t gi = ((size_t)(dir * 32 + g) * 16 + c) * 64 + p;
            CC[i * 2] = c_re[gi]; CC[i * 2 + 1] = c_im[gi]; }
        __syncthreads();
        if (F.tid < 128) { const int dir = F.tid >> 6, p = F.tid & 63;
            aL[((dir * 32 + g) * 64 + p) * 2] = AP[((dir * 65 + 64) * 64 + p) * 2]; aL[((dir * 32 + g) * 64 + p) * 2 + 1] = AP[((dir * 65 + 64) * 64 + p) * 2 + 1]; }
        { const int dir = F.tid >> 8, c = (F.tid >> 4) & 15, c2 = F.tid & 15; float acc[64];
#pragma unroll
            for (int t = 0; t < 64; ++t) acc[t] = 0.f;
            for (int p = 0; p < 64; ++p) { const f32x2 cv = *(const LAS f32x2*)(CC + ((dir * 16 + c) * 64 + p) * 2), bv = *(const LAS f32x2*)(BB + ((dir * 64 + p) * 16 + c2) * 2);
                const float gr = cv[0] * bv[0] - cv[1] * bv[1], gi = cv[0] * bv[1] + cv[1] * bv[0];
#pragma unroll
                for (int t = 0; t < 64; ++t) { const f32x2 av = *(const LAS f32x2*)(AP + ((dir * 65 + t) * 64 + p) * 2); acc[t] += gr * av[0] - gi * av[1]; } }
#pragma unroll
            for (int t = 0; t < 64; ++t) kbuf[(size_t)g * 32768 + (dir << 14) + (t << 8) + (c << 4) + c2] = acc[t]; }
        for (int i = F.tid; i < 256 * 1024; i += NTHR) { const int n = i >> 10, k = i & 1023, dir = n >> 7, reim = (n >> 6) & 1, p = n & 63, ti = k >> 4, c = k & 15;
            const int tau = dir ? ti : 63 - ti;
            const f32x2 av = *(const LAS f32x2*)(AP + ((dir * 65 + tau) * 64 + p) * 2), bv = *(const LAS f32x2*)(BB + ((dir * 64 + p) * 16 + c) * 2);
            const float ar = av[0], ai = av[1], br = bv[0], bi = bv[1];
            const float v = reim ? (ar * bi + ai * br) : (ar * br - ai * bi);
            wst[(size_t)g * 256 * 1024 + i] = (bf16_t)f2bf(v); }
        for (int i = F.tid; i < 1024 * 256; i += NTHR) { const int n = i >> 8, kk = i & 255, dir = kk >> 7, reim = (kk >> 6) & 1, p = kk & 63, ti = n >> 4, c = n & 15;
            const int tau = dir ? 64 - ti : ti + 1;
            const f32x2 av = *(const LAS f32x2*)(AP + ((dir * 65 + tau) * 64 + p) * 2), cv = *(const LAS f32x2*)(CC + ((dir * 16 + c) * 64 + p) * 2);
            const float ar = av[0], ai = av[1], cr = cv[0], ci = cv[1];
            const float v = reim ? -(cr * ai + ci * ar) : (cr * ar - ci * ai);
            btm[((size_t)g * 1024 + n) * 1280 + 1024 + kk] = (bf16_t)f2bf(v); }
    }
    __syncthreads();
}
__device__ __forceinline__ void s5_prep2(const Ctx& F, const float* kbuf, bf16_t* btm) {
    const int gt = F.gw * 64 + F.lane, NT = F.NGW * 64;
    for (int it = gt; it < 32 * 1024 * 128; it += NT) { const int g = it >> 17, n = (it >> 7) & 1023, k8 = it & 127, i = n >> 4, c = n & 15, i2 = k8 >> 1, c2 = (k8 & 1) * 8;
        const float* kb = kbuf + (size_t)g * 32768; float v[8];
        if (i2 < i) { const float* s = kb + ((0 * 64 + (i - i2)) * 16 + c) * 16 + c2;
#pragma unroll
            for (int q = 0; q < 8; ++q) v[q] = s[q]; }
        else if (i2 > i) { const float* s = kb + ((1 * 64 + (i2 - i)) * 16 + c) * 16 + c2;
#pragma unroll
            for (int q = 0; q < 8; ++q) v[q] = s[q]; }
        else { const float* s0 = kb + ((0 * 64 + 0) * 16 + c) * 16 + c2; const float* s1 = kb + ((1 * 64 + 0) * 16 + c) * 16 + c2;
#pragma unroll
            for (int q = 0; q < 8; ++q) v[q] = s0[q] + s1[q]; }
        u32x4 w; w.x = cvt_pk_bf16(v[0], v[1]); w.y = cvt_pk_bf16(v[2], v[3]); w.z = cvt_pk_bf16(v[4], v[5]); w.w = cvt_pk_bf16(v[6], v[7]);
        *(u32x4*)(btm + ((size_t)g * 1024 + n) * 1280 + k8 * 8) = w; }
}
__device__ __forceinline__ void glupool_prep(const Ctx& F, const float* wglu, const float* poolw, bf16_t* wgp, int w0, int nw) {
    weight_prep(F, wglu, 512, 512, wgp, w0, nw);
    const int gt = w0 * 64 + F.lane, NT = nw * 64;
    for (int it = gt; it < 512 * 512; it += NT) { const int n = it >> 9, k = it & 511, gi = n >> 7, d = n & 127;
        const float v = ((k >> 7) == gi) ? poolw[((size_t)gi * 128 + (k & 127)) * 128 + d] : 0.f;
        wgp[(size_t)(512 + n) * 512 + k] = (bf16_t)f2bf(v); }
}

__device__ __forceinline__ void pool_phase(const Ctx& F, const bf16_t* zp, bf16_t* YC, int first, int stride) {
    for (int tok = first; tok < TOK; tok += stride) { const int s = tok & (SEQ - 1), l = F.lane, gi = l >> 4, hw = 1 << gi;
        const int lo = (s - hw) < 0 ? 0 : (s - hw), hiq = (s + hw) > SEQ ? SEQ : (s + hw);
        float a[8];
#pragma unroll
        for (int q = 0; q < 8; ++q) a[q] = 0.f;
        const bf16_t* base = zp + (size_t)(tok - s) * 512 + l * 8;
        u32x4 wv[16];
#pragma unroll
        for (int d = -8; d < 8; ++d) { const int sp = s + d; const bool ok = d >= -hw && d < hw && sp >= 0 && sp < SEQ; wv[d + 8] = *(const u32x4*)(base + (size_t)(ok ? sp : s) * 512); }
#pragma unroll
        for (int d = -8; d < 8; ++d) { const int sp = s + d; const bool ok = d >= -hw && d < hw && sp >= 0 && sp < SEQ; const u32x4 w = wv[d + 8]; const float k = ok ? 1.0f : 0.0f;
                a[0] += k * bf_lo(w.x); a[1] += k * bf_hi(w.x); a[2] += k * bf_lo(w.y); a[3] += k * bf_hi(w.y); a[4] += k * bf_lo(w.z); a[5] += k * bf_hi(w.z); a[6] += k * bf_lo(w.w); a[7] += k * bf_hi(w.w); }
        const float inv = 1.0f / (float)(hiq - lo); const u32x4 w0 = *(const u32x4*)(base + (size_t)s * 512);
        a[0] = a[0] * inv - bf_lo(w0.x); a[1] = a[1] * inv - bf_hi(w0.x); a[2] = a[2] * inv - bf_lo(w0.y); a[3] = a[3] * inv - bf_hi(w0.y);
        a[4] = a[4] * inv - bf_lo(w0.z); a[5] = a[5] * inv - bf_hi(w0.z); a[6] = a[6] * inv - bf_lo(w0.w); a[7] = a[7] * inv - bf_hi(w0.w);
        u32x4 w; w.x = cvt_pk_bf16(a[0], a[1]); w.y = cvt_pk_bf16(a[2], a[3]); w.z = cvt_pk_bf16(a[4], a[5]); w.w = cvt_pk_bf16(a[6], a[7]);
        *(u32x4*)(YC + (size_t)tok * 1024 + 512 + l * 8) = w; }
}

__device__ __forceinline__ void carry_phase(const Ctx& F, const float* spart, const float* aL, bf16_t* zs5) {
    if ((F.gw & 15) != 0) return;
    const int task = F.gw >> 4; if (task >= 128) return;
    const int b = task >> 6, dir = (task >> 5) & 1, g = task & 31, p = F.lane;
    const float ar = aL[((dir * 32 + g) * 64 + p) * 2], ai = aL[((dir * 32 + g) * 64 + p) * 2 + 1];
    float hr = 0.f, hi = 0.f;
    const size_t KS = (size_t)512 * 32 * 256;
    for (int jj = 0; jj < 256; jj += 16) {
        float sr[16], si[16];
#pragma unroll
        for (int u = 0; u < 16; ++u) { const int j = dir ? 255 - (jj + u) : jj + u; const int R = b * 256 + j;
            const float* s = spart + ((size_t)R * 32 + g) * 256 + dir * 128 + p;
            sr[u] = (s[0] + s[KS]) + (s[2 * KS] + s[3 * KS]); si[u] = (s[64] + s[KS + 64]) + (s[2 * KS + 64] + s[3 * KS + 64]); }
#pragma unroll
        for (int u = 0; u < 16; ++u) { const int j = dir ? 255 - (jj + u) : jj + u; const int R = b * 256 + j;
            bf16_t* dst = zs5 + ((size_t)(g * 512 + R) * 1280 + 1024 + dir * 128 + p);
            dst[0] = (bf16_t)f2bf(hr); dst[64] = (bf16_t)f2bf(hi);
            const float nr = ar * hr - ai * hi + sr[u], ni = ar * hi + ai * hr + si[u]; hr = nr; hi = ni; }
    }
}

__device__ __forceinline__ void router_phase(const Ctx& F, const bf16_t* h, const float* gain, const float* wr, float* rs, float* aff) {
    LAS float* WT = (LAS float*)F.lds;
    __syncthreads();
    for (int i = F.tid; i < 16384; i += NTHR) { const int d = i >> 4, e = i & 15; const int c = d >> 5, kq = (d >> 3) & 3, half = (d >> 2) & 1, u4 = d & 3;
        WT[((((c * 4 + kq) * 2 + half) * 16 + e) << 2) + u4] = wr[i] * gain[d]; }
    __syncthreads();
    const int i16 = F.lane & 15, kq = F.lane >> 4;
    for (int tile = F.gw; tile < TOK / 16; tile += F.NGW) {
        const u32x4* xr = (const u32x4*)(h + (size_t)(tile * 16 + i16) * DM) + kq;
        const LAS f32x4* wb = (const LAS f32x4*)WT + kq * 32 + i16;
        f32x4 acc = {0.f, 0.f, 0.f, 0.f}; float ss = 0.f;
#pragma unroll 8
        for (int c = 0; c < 32; ++c) {
            const u32x4 w = xr[4 * c]; const f32x4 b0 = wb[c * 128], b1 = wb[c * 128 + 16];
            const float a0 = bf_lo(w.x), a1 = bf_hi(w.x), a2 = bf_lo(w.y), a3 = bf_hi(w.y), a4 = bf_lo(w.z), a5 = bf_hi(w.z), a6 = bf_lo(w.w), a7 = bf_hi(w.w);
            ss += ((a0 * a0 + a1 * a1) + (a2 * a2 + a3 * a3)) + ((a4 * a4 + a5 * a5) + (a6 * a6 + a7 * a7));
            acc = __builtin_amdgcn_mfma_f32_16x16x4f32(a0, b0[0], acc, 0, 0, 0); acc = __builtin_amdgcn_mfma_f32_16x16x4f32(a1, b0[1], acc, 0, 0, 0);
            acc = __builtin_amdgcn_mfma_f32_16x16x4f32(a2, b0[2], acc, 0, 0, 0); acc = __builtin_amdgcn_mfma_f32_16x16x4f32(a3, b0[3], acc, 0, 0, 0);
            acc = __builtin_amdgcn_mfma_f32_16x16x4f32(a4, b1[0], acc, 0, 0, 0); acc = __builtin_amdgcn_mfma_f32_16x16x4f32(a5, b1[1], acc, 0, 0, 0);
            acc = __builtin_amdgcn_mfma_f32_16x16x4f32(a6, b1[2], acc, 0, 0, 0); acc = __builtin_amdgcn_mfma_f32_16x16x4f32(a7, b1[3], acc, 0, 0, 0);
        }
        ss += __shfl_xor(ss, 16); ss += __shfl_xor(ss, 32);
        const float rstd = __builtin_amdgcn_rsqf(ss * (1.f / DM) + EPS);
        if (F.lane < 16) rs[tile * 16 + F.lane] = rstd;
        const int tok0 = tile * 16 + 4 * kq, bq = tok0 >> 14, sq0 = tok0 & (SEQ - 1);
#pragma unroll
        for (int r = 0; r < 4; ++r) { const float lg = acc[r] * __shfl(rstd, 4 * kq + r);
            float mx = lg; mx = fmaxf(mx, __shfl_xor(mx, 1)); mx = fmaxf(mx, __shfl_xor(mx, 2)); mx = fmaxf(mx, __shfl_xor(mx, 4)); mx = fmaxf(mx, __shfl_xor(mx, 8));
            const float ex = __expf(lg - mx); float sm = ex; sm += __shfl_xor(sm, 1); sm += __shfl_xor(sm, 2); sm += __shfl_xor(sm, 4); sm += __shfl_xor(sm, 8);
            aff[((size_t)(bq * 16 + i16)) * SEQ + sq0 + r] = ex / sm; }
    }
    __syncthreads();
}


__device__ __forceinline__ unsigned block_sum_u(unsigned v, LAS unsigned* red, int& flip, int wave, int lane) {
#pragma unroll
    for (int o = 1; o < 64; o <<= 1) v += __shfl_xor(v, o);
    if (lane == 0) red[flip * 8 + wave] = v;
    __syncthreads();
    unsigned t = 0;
#pragma unroll
    for (int w = 0; w < 8; ++w) t += red[flip * 8 + w];
    flip ^= 1; return t;
}
__device__ __forceinline__ unsigned block_excl_scan_u(unsigned v, LAS unsigned* red, int& flip, int wave, int lane) {
    unsigned inc = v;
#pragma unroll
    for (int o = 1; o < 64; o <<= 1) { const unsigned t = __shfl_up(inc, o); if (lane >= o) inc += t; }
    if (lane == 63) red[flip * 8 + wave] = inc;
    __syncthreads();
    unsigned base = 0;
#pragma unroll
    for (int w = 0; w < 8; ++w) base += (w < wave) ? red[flip * 8 + w] : 0u;
    flip ^= 1; return base + inc - v;
}
__device__ __forceinline__ void select_phase(const Ctx& F, const float* aff, int* idx, float* gate, int* slotmap) {
    LAS unsigned* red = (LAS unsigned*)F.lds; int flip = 0;
    for (int pr = F.vcu; pr < 32; pr += F.G) {
        const int b = pr >> 4, e = pr & 15, ge = e * 2 + b;
        const float* src = aff + (size_t)pr * SEQ + F.tid * 32;
        unsigned key[32];
#pragma unroll
        for (int q = 0; q < 8; ++q) { const u32x4 w = *(const u32x4*)(src + q * 4); key[q * 4] = w.x; key[q * 4 + 1] = w.y; key[q * 4 + 2] = w.z; key[q * 4 + 3] = w.w; }
        unsigned lo = 0u, hi = 0x7f800001u;
        while (hi - lo > 1u) { const unsigned mid = lo + ((hi - lo) >> 1); unsigned c = 0;
#pragma unroll
            for (int q = 0; q < 32; ++q) c += (mid - 1u - key[q]) >> 31;
            const unsigned tot = block_sum_u(c, red, flip, F.wave, F.lane);
            if (tot >= (unsigned)CAP) lo = mid; else hi = mid; }
        const unsigned thr = lo; unsigned cgt = 0, ceq = 0;
#pragma unroll
        for (int q = 0; q < 32; ++q) { cgt += (thr - key[q]) >> 31; const unsigned x = key[q] ^ thr; ceq += 1u - (x < 1u ? x : 1u); }
        const unsigned ngt = block_sum_u(cgt, red, flip, F.wave, F.lane);
        const unsigned need = (unsigned)CAP - ngt;
        const unsigned eqr0 = block_excl_scan_u(ceq, red, flip, F.wave, F.lane);
        unsigned csel = 0, eqr = eqr0;
#pragma unroll
        for (int q = 0; q < 32; ++q) { const unsigned gt = (thr - key[q]) >> 31; const unsigned x = key[q] ^ thr; const unsigned eq = 1u - (x < 1u ? x : 1u);
            csel += gt | (eq & ((eqr - need) >> 31)); eqr += eq; }
        unsigned slot = block_excl_scan_u(csel, red, flip, F.wave, F.lane);
        eqr = eqr0;
        int sm[32];
#pragma unroll
        for (int q = 0; q < 32; ++q) { const unsigned gt = (thr - key[q]) >> 31; const unsigned x = key[q] ^ thr; const unsigned eq = 1u - (x < 1u ? x : 1u);
            const unsigned sel = gt | (eq & ((eqr - need) >> 31)); eqr += eq;
            if (sel) { idx[(size_t)ge * CAP + slot] = F.tid * 32 + q; gate[(size_t)ge * CAP + slot] = __uint_as_float(key[q]); }
            sm[q] = sel ? (int)slot : -1; slot += sel; }
        int* smp = slotmap + (size_t)ge * SEQ + F.tid * 32;
#pragma unroll
        for (int q = 0; q < 8; ++q) { i32x4 w; w.x = sm[q * 4]; w.y = sm[q * 4 + 1]; w.z = sm[q * 4 + 2]; w.w = sm[q * 4 + 3]; *(i32x4*)(smp + q * 4) = w; }
    }
    __syncthreads();
}

__device__ __forceinline__ void combine_phase(const Ctx& F, const bf16_t* hin, bf16_t* hout, float* fout, const bf16_t* YB, const int* slotmap, const float* gnext, bf16_t* N) {
    f32x4 g4[4];
#pragma unroll
    for (int j = 0; j < 4; ++j) g4[j] = gnext ? ((const f32x4*)gnext)[F.lane + 64 * j] : (f32x4){0.f, 0.f, 0.f, 0.f};
    int sm_next = -1; if (F.gw < TOK && F.lane < 16) sm_next = slotmap[((size_t)(F.lane * 2 + (F.gw >> 14))) * SEQ + (F.gw & (SEQ - 1))];
    for (int tok = F.gw; tok < TOK; tok += F.NGW) { const int b = tok >> 14;
        const int sm = sm_next; { const int tn = tok + F.NGW; sm_next = -1; if (tn < TOK && F.lane < 16) sm_next = slotmap[((size_t)(F.lane * 2 + (tn >> 14))) * SEQ + (tn & (SEQ - 1))]; }
        unsigned long long mask = __ballot(sm >= 0);
        const u32x2* xr = (const u32x2*)(hin + (size_t)tok * DM) + F.lane; f32x4 v[4]; u32x2 hw[4];
#pragma unroll
        for (int j = 0; j < 4; ++j) hw[j] = xr[64 * j];
        bool first = true;
        do {
            u32x2 y[4][4];
#pragma unroll
            for (int i = 0; i < 4; ++i) { const bool ok = mask != 0ull; const int e = ok ? __builtin_ctzll(mask) : 0; mask &= mask - 1ull; const int slot = __shfl(sm, e);
                const u32x2* yr = (const u32x2*)(YB + ((size_t)(e * 2 + b) * CAP + (ok ? slot : 0)) * DM) + F.lane;
#pragma unroll
                for (int j = 0; j < 4; ++j) y[i][j] = ok ? yr[64 * j] : (u32x2){0u, 0u}; }
            if (first) { first = false;
#pragma unroll
                for (int j = 0; j < 4; ++j) v[j] = (f32x4){bf_lo(hw[j].x), bf_hi(hw[j].x), bf_lo(hw[j].y), bf_hi(hw[j].y)}; }
#pragma unroll
            for (int i = 0; i < 4; ++i)
#pragma unroll
                for (int j = 0; j < 4; ++j) { v[j][0] += bf_lo(y[i][j].x); v[j][1] += bf_hi(y[i][j].x); v[j][2] += bf_lo(y[i][j].y); v[j][3] += bf_hi(y[i][j].y); }
        } while (mask);
        float ss = 0.f;
        if (fout) { f32x4* orow = (f32x4*)(fout + (size_t)tok * DM) + F.lane;
#pragma unroll
            for (int j = 0; j < 4; ++j) orow[64 * j] = v[j]; }
        else { u32x2* orow = (u32x2*)(hout + (size_t)tok * DM) + F.lane;
#pragma unroll
            for (int j = 0; j < 4; ++j) { u32x2 w; w.x = cvt_pk_bf16(v[j][0], v[j][1]); w.y = cvt_pk_bf16(v[j][2], v[j][3]); orow[64 * j] = w; } }
#pragma unroll
        for (int j = 0; j < 4; ++j) { ss += (v[j][0] * v[j][0] + v[j][1] * v[j][1]) + (v[j][2] * v[j][2] + v[j][3] * v[j][3]); }
        if (gnext) { const float rstd = __builtin_amdgcn_rsqf(wave_sum(ss) * (1.f / DM) + EPS); u32x2* o8 = (u32x2*)(N + (size_t)tok * DM) + F.lane;
#pragma unroll
            for (int j = 0; j < 4; ++j) { const f32x4 y = v[j] * rstd * g4[j]; u32x2 w; w.x = cvt_pk_bf16(y[0], y[1]); w.y = cvt_pk_bf16(y[2], y[3]); o8[64 * j] = w; } }
    }
}

#define PHASE_BEGIN unsigned char* ws = (unsigned char*)getp(lds_raw, 32)
#define INF(k) ((const float*)getp(lds_raw, (k)))
#define WSP(T, off) ((T*)(ws + (off)))
#define GRID_BAR() do { unsigned char* wsb_ = (unsigned char*)getp(lds_raw, 32); XcdBarrier bar_; bar_.bar = (unsigned*)(wsb_ + WS_CTL) + CW_BAR; bar_.x = xb_xcc_id(); \
    bar_.st = (volatile LAS unsigned*)((LAS unsigned char*)lds_raw + MISC_OFF) + 8; xcd_barrier(bar_); } while (0)
#define MKCTX() Ctx F; F.lds = (LAS unsigned char*)lds_raw; { int t_ = threadIdx.x; asm volatile("" : "+v"(t_)); F.tid = t_; } F.lane = F.tid & 63; F.wave = __builtin_amdgcn_readfirstlane(F.tid >> 6); \
    F.G = GRID; { int bx = blockIdx.x; asm volatile("" : "+s"(bx)); F.vcu = (bx & 7) * (GRID / 8) + (bx >> 3); } F.gw = F.vcu * NWAVES + F.wave; F.NGW = GRID * NWAVES

__global__ void __launch_bounds__(NTHR, 2) mega_fwd(Params P) {
    extern __shared__ __attribute__((aligned(16))) unsigned char lds_raw[];
    {
        const int tid = threadIdx.x;
        for (int u = tid; u < (LDS_BYTES - LDSCTL_OFF) / 4; u += NTHR) ((LAS unsigned*)((LAS unsigned char*)lds_raw + LDSCTL_OFF))[u] = 0u;
        __syncthreads();
        if (tid == 0) { LAS unsigned long long* tab = (LAS unsigned long long*)((LAS unsigned char*)lds_raw + PTAB_OFF);
#pragma unroll
            for (int k = 0; k < 31; ++k) tab[k] = (unsigned long long)P.in[k];
            tab[31] = (unsigned long long)P.out; tab[32] = (unsigned long long)P.ws; }
        __syncthreads();
        (void)xcd_barrier_post((unsigned*)(P.ws + WS_CTL) + CW_BAR, (volatile LAS unsigned*)((LAS unsigned char*)lds_raw + MISC_OFF) + 8);
    }
    {
        PHASE_BEGIN; MKCTX();
        const int* pos = (const int*)getp(lds_raw, 1); float* COS = WSP(float, WS_COS); float* SIN = WSP(float, WS_SIN); const float* x = INF(0); bf16_t* N = WSP(bf16_t, WS_N);
        const int gt = F.gw * 64 + F.lane, NT = F.NGW * 64;
        for (int it = gt; it < TOK * 32; it += NT) { const int tok = it >> 5, i = it & 31;
            const float inv = __builtin_amdgcn_exp2f(-(float)i * (13.287712379549449f / 32.0f));
            const float ang = (float)pos[tok] * inv; float s, c; sincos_big((double)ang, s, c); COS[it] = c; SIN[it] = s; }
        f32x4 g4[4];
#pragma unroll
        for (int j = 0; j < 4; ++j) g4[j] = ((const f32x4*)INF(2))[F.lane + 64 * j];
        for (int tok = F.gw; tok < TOK; tok += F.NGW) rms_row_to_bf16(x + (size_t)tok * DM, g4, N + (size_t)tok * DM, F.lane);
    }

    for (int l = 0; l < DBG_LAYERS; ++l) {
        const int ev = l >> 1; const bool even = (l & 1) == 0;
        if (PH(0)) REP(0) {
            PHASE_BEGIN; MKCTX();
            const bool s5blk = even && F.vcu < 32;
            const int w0 = even ? F.gw - 32 * NWAVES : F.gw, nw = even ? F.NGW - 32 * NWAVES : F.NGW;
            if (s5blk) s5_prep1(F, lds_raw, ev, WSP(bf16_t, WS_WST), WSP(bf16_t, WS_BTM), WSP(float, WS_KBUF), WSP(float, WS_AL));
            else {
                moe_weight_prep(F, INF(28) + (size_t)l * 16 * 1024 * 2048, INF(29) + (size_t)l * 16 * 1024 * 2048, INF(30) + (size_t)l * 16 * 2048 * 1024, INF(3) + (size_t)l * DM, WSP(bf16_t, WS_BT1), WSP(bf16_t, WS_BT2), w0, nw, MOE_PREP_HEAD);
                if (even) {
                    weight_prep(F, INF(4) + (size_t)ev * 1024 * 1024, 1024, 1024, WSP(bf16_t, WS_WIN), w0, nw);
                    weight_prep(F, INF(5) + (size_t)ev * 1024 * 1024, 1024, 1024, WSP(bf16_t, WS_WOUT), w0, nw);
                    glupool_prep(F, INF(14) + (size_t)ev * 512 * 512, INF(16) + (size_t)ev * 4 * 128 * 128, WSP(bf16_t, WS_WGP), w0, nw);
                } else {
                    weight_prep<RmQK>(F, INF(18) + (size_t)ev * 1024 * 3072, 1024, 3072, WSP(bf16_t, WS_WIN), w0, nw);
                    weight_prep(F, INF(19) + (size_t)ev * 1024 * 1024, 1024, 1024, WSP(bf16_t, WS_WOUT), w0, nw);
                }
            }
        }
        GRID_BAR();
#if DBG_MIX
        if (even) {
            if (PH(1)) REP(1) {
                { PHASE_BEGIN; MKCTX(); s5_prep2(F, WSP(float, WS_KBUF), WSP(bf16_t, WS_BTM)); }
                {
                    PHASE_BEGIN; MKCTX();
                    pg8::Cfg g{2048u, 2048u, 1024}; pg8::PlainOrder S; S.init(TOK, 1024, GRID, (int)blockIdx.x, WSP(bf16_t, WS_N), WSP(bf16_t, WS_WIN), 2048u, 2048u);
                    pg8::EpiZ E{WSP(bf16_t, WS_ZS5), WSP(bf16_t, WS_ZP)};
                    pg8::gemm_phase(F.lds, g, S, E);
                }
            }
            GRID_BAR();
            if (PH(2)) REP(2) {
                {
                    PHASE_BEGIN; MKCTX();
                    pg8::Cfg g{2560u, 2048u, 256}; pg8::S5Order S{GRID, F.vcu, (const char*)WSP(bf16_t, WS_ZS5), (const char*)WSP(bf16_t, WS_WST), (size_t)512 * 2560, (size_t)256 * 2560, (size_t)256 * 2048, 512, 512};
                    pg8::EpiState E{WSP(float, WS_SPART)};
                    pg8::gemm_phase(F.lds, g, S, E);
                }
            }
            GRID_BAR();
            if (PH(3)) REP(3) { PHASE_BEGIN; MKCTX();
                if ((F.gw & 15) == 0) carry_phase(F, WSP(float, WS_SPART), WSP(float, WS_AL), WSP(bf16_t, WS_ZS5));
                else pool_phase(F, WSP(bf16_t, WS_ZP), WSP(bf16_t, WS_YC), F.gw - (F.gw >> 4) - 1, F.NGW - F.NGW / 16); }
            GRID_BAR();
            if (PH(4)) REP(4) {
                PHASE_BEGIN; MKCTX();
                pg8::Cfg g{2560u, 2560u, 1280}; pg8::S5Order S{GRID, F.vcu, (const char*)WSP(bf16_t, WS_ZS5), (const char*)WSP(bf16_t, WS_BTM), (size_t)512 * 2560, (size_t)256 * 2560, (size_t)1024 * 2560, 0, (size_t)256 * 2560};
                pg8::EpiS5 E{WSP(bf16_t, WS_ZS5), INF(13) + (size_t)ev * 512, WSP(bf16_t, WS_YC)};
                pg8::gemm_phase(F.lds, g, S, E);
            }
            GRID_BAR();
            if (PH(5)) REP(5) {
                PHASE_BEGIN; MKCTX();
                pg8::Cfg g{2048u, 1024u, 512}; pg8::PlainOrder S; S.init(TOK, 1024, GRID, (int)blockIdx.x, WSP(bf16_t, WS_YC), WSP(bf16_t, WS_WGP), 2048u, 1024u); S.a_pn_split = 2; S.a_pn_off = 1024;
                pg8::EpiGluPool E{WSP(bf16_t, WS_YC), INF(15) + (size_t)ev * 512, INF(17) + (size_t)ev * 512, WSP(bf16_t, WS_MIX)};
                pg8::gemm_phase(F.lds, g, S, E);
            }
            GRID_BAR();
        } else {
            if (PH(6)) REP(6) {
                PHASE_BEGIN; MKCTX();
                pg8::Cfg g{2048u, 2048u, 1024}; pg8::PlainOrder S; S.init(TOK, 3072, GRID, (int)blockIdx.x, WSP(bf16_t, WS_N), WSP(bf16_t, WS_WIN), 2048u, 2048u);
                pg8::EpiQKV E{WSP(bf16_t, WS_Q), (size_t)(WS_K - WS_Q) / 2, WSP(float, WS_COS), WSP(float, WS_SIN), INF(20) + ev * 64, INF(21) + ev * 64, (LAS float*)(F.lds + GTAB_OFF)};
                pg8::gemm_phase(F.lds, g, S, E);
            }
            GRID_BAR();
            if (PH(8)) REP(8) {
                PHASE_BEGIN; MKCTX();
                const float lam_init = 0.8f - 0.6f * __expf(-0.3f * (float)l);
                const float d1 = wave_sum(INF(22)[ev * 64 + F.lane] * INF(23)[ev * 64 + F.lane]);
                const float d2 = wave_sum(INF(24)[ev * 64 + F.lane] * INF(25)[ev * 64 + F.lane]);
                const float lam = __expf(d1) - __expf(d2) + lam_init;
                const bf16_t* QB = WSP(bf16_t, WS_Q); const bf16_t* KB = WSP(bf16_t, WS_K); const bf16_t* VB = WSP(bf16_t, WS_V); bf16_t* MIX = WSP(bf16_t, WS_MIX); const float* subg = INF(26) + ev * 128;
                bf16x8 qr[2][2] = {};
                for (int i = 0;; ++i) { const int u = i * GRID + F.vcu; if (u >= BATCH * 8 * 128) break;
                    const int bh = u >> 7, qb = u & 127, un = u + GRID, bhn = un >> 7;
                    att::attn_unit16(F.lds, QB, KB, VB, MIX, bh >> 3, bh & 7, qb, lam, 1.0f - lam_init, subg, qr, i == 0, un < BATCH * 8 * 128, bhn >> 3, bhn & 7); }
            }
            GRID_BAR();
        }
        if (PH(9)) REP(9) {
            PHASE_BEGIN; MKCTX();
            pg8::Cfg g{2048u, 2048u, 1024}; pg8::PlainOrder S; S.init(TOK, 1024, GRID, (int)blockIdx.x, WSP(bf16_t, WS_MIX), WSP(bf16_t, WS_WOUT), 2048u, 2048u);
            pg8::EpiResB E{(l == 0) ? INF(0) : (const float*)nullptr, WSP(bf16_t, WS_H), WSP(bf16_t, WS_H)};
            pg8::gemm_phase(F.lds, g, S, E);
        }
        GRID_BAR();
#else
        if (l == 0) { PHASE_BEGIN; MKCTX(); const int gt = F.gw * 64 + F.lane, NT = F.NGW * 64; for (int it = gt; it < TOK * DM / 4; it += NT) WSP(f32x4, WS_H)[it] = ((const f32x4*)INF(0))[it]; GRID_BAR(); }
#endif
#if DBG_MOE
        if (PH(10)) REP(10) { PHASE_BEGIN; MKCTX(); router_phase(F, WSP(bf16_t, WS_H), INF(3) + (size_t)l * DM, INF(27) + (size_t)l * DM * NE, WSP(float, WS_RSMOE), WSP(float, WS_AFF)); }
        GRID_BAR();
        if (PH(11)) REP(11) { PHASE_BEGIN; MKCTX();
            if (F.vcu < 32) select_phase(F, WSP(float, WS_AFF), WSP(int, WS_IDX), WSP(float, WS_GATE), WSP(int, WS_SLOT));
            else moe_weight_prep(F, INF(28) + (size_t)l * 16 * 1024 * 2048, INF(29) + (size_t)l * 16 * 1024 * 2048, INF(30) + (size_t)l * 16 * 2048 * 1024, INF(3) + (size_t)l * DM, WSP(bf16_t, WS_BT1), WSP(bf16_t, WS_BT2), MOE_PREP_HEAD + F.gw - 32 * NWAVES, F.NGW - 32 * NWAVES); }
        GRID_BAR();
        for (int hf = 0; hf < 2; ++hf) {
        if (PH(13)) REP(13) { PHASE_BEGIN; MKCTX();
            LAS unsigned* gt = (LAS unsigned*)(F.lds + GTAB_OFF); const int* idx = WSP(int, WS_IDX);
            const int pml = ((F.vcu >> 5) >> 1) * 4 + ((F.vcu & 31) >> 3);
            for (int j = F.tid; j < 8 * 256; j += NTHR) { const int pm = (8 * hf + (j >> 8)) * 16 + pml, bq = (pm >> 3) & 1; const int tk = bq * SEQ + idx[pm * 256 + (j & 255)]; gt[j] = (unsigned)tk * 2048u; ((LAS float*)(gt + 2048))[j] = WSP(float, WS_RSMOE)[tk]; }
            __syncthreads();
            pg8::Cfg g{2048u, 2048u, 1024}; pg8::Moe1Order S{GRID, F.vcu, (const char*)WSP(bf16_t, WS_H), (const char*)WSP(bf16_t, WS_BT1), 8 * hf, 8};
            pg8::EpiSwiglu E{WSP(bf16_t, WS_HMID), (const LAS float*)(gt + 2048)};
            pg8::gemm_phase<pg8::EpiSwiglu, pg8::Moe1Order, true>(F.lds, g, S, E, gt); }
        GRID_BAR();
        if (PH(14)) REP(14) { PHASE_BEGIN; MKCTX(); pg8::Cfg g{4096u, 4096u, 2048}; pg8::Moe2Order S{GRID, F.vcu, (const char*)WSP(bf16_t, WS_HMID), (const char*)WSP(bf16_t, WS_BT2), 8 * hf, 8};
            pg8::EpiGate E{WSP(bf16_t, WS_YB), WSP(float, WS_GATE)};
            pg8::gemm_phase(F.lds, g, S, E); }
        GRID_BAR();
        }
        if (PH(15)) REP(15) { PHASE_BEGIN; MKCTX(); combine_phase(F, WSP(bf16_t, WS_H), WSP(bf16_t, WS_H), (l == 3) ? (float*)getp(lds_raw, 31) : (float*)nullptr, WSP(bf16_t, WS_YB), WSP(int, WS_SLOT), (l < 3) ? INF(2) + (size_t)(l + 1) * DM : nullptr, WSP(bf16_t, WS_N)); }
#else
        {
            PHASE_BEGIN; MKCTX();
            const float* gnext = (l < 3) ? INF(2) + (size_t)(l + 1) * DM : nullptr; float* H = WSP(float, WS_H); bf16_t* N = WSP(bf16_t, WS_N);
            f32x4 g4[4];
#pragma unroll
            for (int j = 0; j < 4; ++j) g4[j] = gnext ? ((const f32x4*)gnext)[F.lane + 64 * j] : (f32x4){0.f, 0.f, 0.f, 0.f};
            if (gnext) for (int tok = F.gw; tok < TOK; tok += F.NGW) rms_row_to_bf16(H + (size_t)tok * DM, g4, N + (size_t)tok * DM, F.lane);
            if (l == 3) { const int gt = F.gw * 64 + F.lane, NT = F.NGW * 64; for (int it = gt; it < TOK * DM / 4; it += NT) ((f32x4*)getp(lds_raw, 31))[it] = ((const f32x4*)H)[it]; }
            GRID_BAR();
        }
#endif
    }
#if DBG_LAYERS < 4
    {   PHASE_BEGIN; MKCTX(); const int gt = F.gw * 64 + F.lane, NT = F.NGW * 64; const float* src = (DBG_LAYERS == 0) ? INF(0) : (const float*)WSP(float, WS_H);
        for (int it = gt; it < TOK * DM / 4; it += NT) ((f32x4*)getp(lds_raw, 31))[it] = ((const f32x4*)src)[it]; }
#endif
}

extern "C" void kernel_launch(void* const* d_in, const int* in_sizes, int n_in, void* d_out, int out_size, void* d_ws, size_t ws_size, hipStream_t stream) {
    static int grid = 0;
    if (grid == 0) {
        if (n_in != 31 || out_size != TOK * DM || ws_size < WS_END) { fprintf(stderr, "kernel_launch: unexpected shapes: n_in %d out %d ws %zu (need %zu)\n", n_in, out_size, ws_size, (size_t)WS_END); grid = -1; return; }
        int dev = 0, cus = 0, per_cu = 0;
        if (hipGetDevice(&dev) != hipSuccess || hipDeviceGetAttribute(&cus, hipDeviceAttributeMultiprocessorCount, dev) != hipSuccess) { grid = -1; return; }
        if (hipFuncSetAttribute((const void*)mega_fwd, hipFuncAttributeMaxDynamicSharedMemorySize, LDS_BYTES) != hipSuccess) { fprintf(stderr, "kernel_launch: hipFuncSetAttribute failed\n"); grid = -1; return; }
        if (hipOccupancyMaxActiveBlocksPerMultiprocessor(&per_cu, (const void*)mega_fwd, NTHR, LDS_BYTES) != hipSuccess || per_cu < 1)
            fprintf(stderr, "kernel_launch: note: occupancy query reports %d workgroups per CU\n", per_cu);
        (void)hipGetLastError();
        if (cus < GRID) { fprintf(stderr, "kernel_launch: this kernel needs %d CUs (device has %d)\n", GRID, cus); grid = -1; return; }
        grid = GRID;
    }
    if (grid < 0) return;
    if (hipMemsetAsync((char*)d_ws + WS_CTL, 0, CTL_ZERO_BYTES, stream) != hipSuccess) { fprintf(stderr, "kernel_launch: memset failed\n"); return; }
    Params p{};
    for (int i = 0; i < 31; ++i) p.in[i] = d_in[i];
    p.out = (float*)d_out; p.ws = (unsigned char*)d_ws;
    hipLaunchKernelGGL(mega_fwd, dim3(grid), dim3(NTHR), LDS_BYTES, stream, p);
    const hipError_t le = hipPeekAtLastError();
    if (le != hipSuccess) fprintf(stderr, "kernel_launch: launch failed: %s\n", hipGetErrorName(le));
}
```

```cpp
#include <hip/hip_runtime.h>
#include <cstdio>
#include <cstdint>

#define GAS __attribute__((address_space(1)))
#define LAS __attribute__((address_space(3)))
typedef unsigned short bf16_t;
typedef short bf16x8 __attribute__((ext_vector_type(8)));
typedef short s16x4 __attribute__((ext_vector_type(4)));
typedef float f32x4 __attribute__((ext_vector_type(4)));
typedef float f32x2 __attribute__((ext_vector_type(2)));
typedef float f32x16 __attribute__((ext_vector_type(16)));
typedef unsigned u32x4 __attribute__((ext_vector_type(4)));
typedef unsigned u32x2 __attribute__((ext_vector_type(2)));
typedef int i32x4 __attribute__((ext_vector_type(4)));

#ifndef DBG_LAYERS
#define DBG_LAYERS 4
#endif
#ifndef DBG_MIX
#define DBG_MIX 1
#endif
#ifndef DBG_MOE
#define DBG_MOE 1
#endif
#ifndef DBG_PH
#define DBG_PH 0xFFFFFFFFu
#endif
#define PH(k) ((DBG_PH >> (k)) & 1u)
#ifndef DBG_REP
#define DBG_REP 0u
#endif
#define REP(k) for (int rep_ = 0; rep_ < 1 + (int)((DBG_REP >> (k)) & 1u); ++rep_)

constexpr int DM = 1024, BATCH = 2, SEQ = 16384, TOK = BATCH * SEQ, NE = 16, FF = 2048, CAP = 2048, NROW = BATCH * NE * CAP;
constexpr int NWAVES = 8, NTHR = 512, GRID = 256;
constexpr float EPS = 1e-6f;
constexpr float LOG2E = 1.4426950408889634f;
constexpr float QSCALE = 0.125f * LOG2E;

constexpr size_t MiB = 1u << 20;
constexpr size_t WS_CTL = 0, CTL_ZERO_BYTES = 1 * MiB;
constexpr size_t WS_COS = 2 * MiB, WS_SIN = 6 * MiB;
constexpr size_t WS_AFF = 10 * MiB;
constexpr size_t WS_SLOT = 12 * MiB;
constexpr size_t WS_IDX = 14 * MiB;
constexpr size_t WS_GATE = 14 * MiB + 512 * 1024;
constexpr size_t WS_AL = 15 * MiB;
constexpr size_t WS_KBUF = 16 * MiB;
constexpr size_t WS_WIN = 20 * MiB;
constexpr size_t WS_WOUT = 26 * MiB;
constexpr size_t WS_WGP = 28 * MiB;
constexpr size_t WS_WST = 32 * MiB;
constexpr size_t WS_BTM = 48 * MiB;
constexpr size_t WS_BT1 = 128 * MiB;
constexpr size_t WS_BT2 = 256 * MiB;
constexpr size_t WS_RSMOE = 832 * MiB;
constexpr size_t WS_H = 320 * MiB;
constexpr size_t WS_N = 448 * MiB;
constexpr size_t WS_ZS5 = 512 * MiB;
constexpr size_t WS_ZP = 576 * MiB;
constexpr size_t WS_SPART = 640 * MiB;
constexpr size_t WS_Q = WS_ZS5, WS_K = WS_ZP, WS_V = WS_SPART;
constexpr size_t WS_YC = 704 * MiB;
constexpr size_t WS_MIX = 768 * MiB;
constexpr size_t WS_XG = 832 * MiB;
constexpr size_t WS_HMID = 960 * MiB;
constexpr size_t WS_YB = 1216 * MiB;
constexpr size_t WS_END = 1344 * MiB;
constexpr int CW_BAR = 4096;

constexpr int RING_BYTES = 131072;
constexpr int LDSCTL_OFF = RING_BYTES, MISC_OFF = LDSCTL_OFF + 320;
constexpr int GTAB_OFF = 133120;
constexpr int LDS_BYTES = 151552;

constexpr int PTAB_OFF = LDSCTL_OFF + 512;
__device__ __forceinline__ const void* getp(const unsigned char* lds_raw_, int k) {
    const LAS unsigned* t = (const LAS unsigned*)((const LAS unsigned char*)lds_raw_ + PTAB_OFF) + 2 * k;
    const unsigned lo = __builtin_amdgcn_readfirstlane(t[0]), hi = __builtin_amdgcn_readfirstlane(t[1]);
    return (const void*)(const GAS void*)(((unsigned long long)hi << 32) | lo);
}
#define RLX_AGENT __ATOMIC_RELAXED, __HIP_MEMORY_SCOPE_AGENT
#define LDS_WAIT() asm volatile("s_waitcnt lgkmcnt(0)" ::: "memory")
#define VM_WAIT() asm volatile("s_waitcnt vmcnt(0)" ::: "memory")
__device__ __forceinline__ unsigned cvt_pk_bf16(float lo, float hi) { unsigned r; asm volatile("v_cvt_pk_bf16_f32 %0, %1, %2" : "=v"(r) : "v"(lo), "v"(hi)); return r; }
__device__ __forceinline__ unsigned f2bf(float f) { return cvt_pk_bf16(f, 0.f) & 0xffffu; }
__device__ __forceinline__ float bf_lo(unsigned w) { return __uint_as_float(w << 16); }
__device__ __forceinline__ float bf_hi(unsigned w) { return __uint_as_float(w & 0xffff0000u); }
__device__ __forceinline__ float wave_sum(float v) {
#pragma unroll
    for (int o = 1; o < 64; o <<= 1) v += __shfl_xor(v, o);
    return v;
}
__device__ __forceinline__ float fast_exp2(float x) { return __builtin_amdgcn_exp2f(x); }
__device__ __forceinline__ float fast_rcp(float x) { return __builtin_amdgcn_rcpf(x); }
__device__ __forceinline__ float sigmoidf_fast(float x) { return fast_rcp(1.0f + fast_exp2(-x * LOG2E)); }
__device__ __forceinline__ float gelu_tanh(float y) { const float u = 0.7978845608028654f * (y + 0.044715f * y * y * y); return y * sigmoidf_fast(2.0f * u); }
__device__ __forceinline__ void sincos_big(double ang, float& s, float& c) {
    const double rev = ang * 0.15915494309189533577; const double fr = rev - __builtin_rint(rev); const float f = (float)fr;
    s = __builtin_amdgcn_sinf(f); c = __builtin_amdgcn_cosf(f);
}

#define XB_TMO      128
#define XB_XCNT(j)  (256  + 64 * (j))
#define XB_XSUB(j)  (1280 + 64 * (j))
#define XB_XGEN(j)  (2304 + 64 * (j))
#define XB_TOP      3328
#define XB_TOPGEN   3392
#define XCD_BAR_WORDS 3456
#define XB_SPIN_CAP (1u << 22)
__device__ __forceinline__ unsigned xb_ld(unsigned* p)              { return __hip_atomic_load(p, __ATOMIC_RELAXED, __HIP_MEMORY_SCOPE_AGENT); }
__device__ __forceinline__ unsigned xb_add(unsigned* p, unsigned v) { return __hip_atomic_fetch_add(p, v, __ATOMIC_RELAXED, __HIP_MEMORY_SCOPE_AGENT); }
__device__ __forceinline__ unsigned xb_xcc_id() { return (unsigned)__builtin_amdgcn_s_getreg((3 << 11) | 20) & 0xFu; }
#define XB_SPIN(cond, bar) do { unsigned _sp = 0; while (cond) { __builtin_amdgcn_s_sleep(1); \
    if ((++_sp & 255u) == 0u) { if (xb_ld(&(bar)[XB_TMO])) break; if (_sp > XB_SPIN_CAP) { atomicAdd(&(bar)[XB_TMO], 1u); break; } } } } while (0)
struct XcdBarrier { unsigned* bar; unsigned x; volatile LAS unsigned* st; };
__device__ __forceinline__ XcdBarrier xcd_barrier_post(unsigned* bar, volatile LAS unsigned* st) {
    XcdBarrier b; b.bar = bar; b.x = xb_xcc_id(); b.st = st;
    if (threadIdx.x == 0) (void)xb_add(&bar[XB_XCNT(b.x)], 1u);
    return b;
}
__device__ __forceinline__ void xcd_barrier_complete(unsigned* bar, unsigned x, unsigned& nloc, unsigned& nx) {
    const unsigned G = gridDim.x * gridDim.y * gridDim.z;
    unsigned sum, cnt, mine, sp = 0u;
    for (;;) {
        sum = 0u; cnt = 0u; mine = 0u;
#pragma unroll
        for (unsigned j = 0; j < 16; ++j) { const unsigned c = xb_ld(&bar[XB_XCNT(j)]); sum += c; cnt += (c > 0u) ? 1u : 0u; mine = (j == x) ? c : mine; }
        if (sum == G) break;
        __builtin_amdgcn_s_sleep(1);
        if ((++sp & 255u) == 0u) { if (xb_ld(&bar[XB_TMO])) break; if (sp > XB_SPIN_CAP) { atomicAdd(&bar[XB_TMO], 1u); break; } }
    }
    nloc = mine > 0u ? mine : 1u; nx = cnt > 0u ? cnt : 1u;
}
__device__ __forceinline__ void xcd_barrier(const XcdBarrier& b) {
    asm volatile("s_waitcnt vmcnt(0)" ::: "memory");
    __syncthreads();
    if (threadIdx.x == 0) {
        unsigned* bar = b.bar;
        __builtin_amdgcn_s_waitcnt(0);
        unsigned nloc = b.st[0], nx = b.st[1];
        if (nloc == 0u) { xcd_barrier_complete(bar, b.x, nloc, nx); b.st[0] = nloc; b.st[1] = nx; }
        const unsigned old = xb_add(&bar[XB_XSUB(b.x)], 1u);
        const unsigned gen = old / nloc;
        if (old + 1u == (gen + 1u) * nloc) {
            __builtin_amdgcn_fence(__ATOMIC_RELEASE, "agent");
            asm volatile("s_waitcnt vmcnt(0)" ::: "memory");
            const unsigned og = xb_add(&bar[XB_TOP], 1u);
            const unsigned tg = og / nx;
            if (og + 1u == (tg + 1u) * nx) xb_add(&bar[XB_TOPGEN], 1u);
            else XB_SPIN(xb_ld(&bar[XB_TOPGEN]) == tg, bar);
            __builtin_amdgcn_fence(__ATOMIC_ACQUIRE, "agent");
            xb_add(&bar[XB_XGEN(b.x)], 1u);
            asm volatile("s_waitcnt vmcnt(0)" ::: "memory");
        } else {
            XB_SPIN(xb_ld(&bar[XB_XGEN(b.x)]) == gen, bar);
            __builtin_amdgcn_fence(__ATOMIC_ACQUIRE, "agent");
            asm volatile("s_waitcnt vmcnt(0)" ::: "memory");
        }
    }
    __syncthreads();
}

__device__ __forceinline__ void glds16_sv(unsigned voff, const char* sbase, unsigned lds_dst) {
    asm volatile("s_mov_b32 m0, %2\n\ts_nop 0\n\tglobal_load_lds_dwordx4 %0, %1" : : "v"(voff), "s"(sbase), "s"(lds_dst) : "memory", "m0"); }
__device__ __forceinline__ void glds16_sv2(unsigned voff0, unsigned voff1, const char* sbase, unsigned lds_dst) { unsigned t_;
    asm volatile("s_mov_b32 m0, %4\n\ts_add_i32 %0, %4, 0x2000\n\tglobal_load_lds_dwordx4 %1, %3\n\ts_mov_b32 m0, %0\n\ts_nop 0\n\tglobal_load_lds_dwordx4 %2, %3"
                 : "=&s"(t_) : "v"(voff0), "v"(voff1), "s"(sbase), "s"(lds_dst) : "memory", "m0", "scc"); }
namespace pg8 {
constexpr int BM = 256, BK = 64, HALF = 128, HTB = HALF * BK * 2, STAGE_BYTES = 8 * HTB;
__host__ __device__ __forceinline__ int lds_byte(int r, int c) { const int st = (r >> 4) * 2 + (c >> 5), rr = r & 15, cc = c & 31, ob = rr * 64 + cc * 2; return st * 1024 + (ob ^ (((ob >> 9) & 1) << 5)); }
__host__ __device__ __forceinline__ void stage_rc(int b, int& R, int& C) { const int st = b / 1024, sb = b % 1024, swz = sb ^ (((sb >> 9) & 1) << 5); R = (st >> 1) * 16 + swz / 64; C = (st & 1) * 32 + (swz % 64) / 2; }
__host__ __device__ __forceinline__ int perm32(int rho) { const int n = rho >> 4, i = rho & 15; return 8 * (i >> 2) + 4 * n + (i & 3); }

struct Unit { int pm, pn, pg; const char* a; const char* b; };
struct Cfg { unsigned a_row, b_row; int K; };

template <class Epi, class Sched, bool GATHER = false>
__device__ __forceinline__ void gemm_phase(LAS unsigned char* lds, const Cfg g, const Sched& S, const Epi& E, const LAS unsigned* gtab = nullptr) {
    int tid_ = threadIdx.x; asm volatile("" : "+v"(tid_));
    const int tid = tid_, wid = __builtin_amdgcn_readfirstlane(tid >> 6), lane = tid & 63, wr = wid >> 2, wc = wid & 3, fr = lane & 15, fq = lane >> 4;
    int Kr_ = g.K; asm volatile("" : "+s"(Kr_));
    const int nt = Kr_ / BK;
    unsigned vA[2][2], vAn[2][2], voffB[2]; int RA[2], CA2[2];
#pragma unroll
    for (int i = 0; i < 2; ++i) { int R, C; stage_rc(tid * 16 + i * 8192, R, C); const int Rb = Epi::PERM ? ((R & ~31) + perm32(R & 31)) : R; RA[i] = R; CA2[i] = C * 2;
        voffB[i] = (unsigned)Rb * g.b_row + (unsigned)C * 2u;
#pragma unroll
        for (int h = 0; h < 2; ++h) { if constexpr (GATHER) vA[h][i] = gtab[h * HALF + R] + (unsigned)(C * 2); else vA[h][i] = (unsigned)(R + h * HALF) * g.a_row + (unsigned)C * 2u; vAn[h][i] = vA[h][i]; } }
    const size_t kstep = (size_t)(BK * 2);
    const size_t hstepB = (size_t)HALF * g.b_row;
    const unsigned ldsw = (unsigned)wid * 1024u, lds0_ = (unsigned)(size_t)lds;
    const int aoff = lds_byte(wr * 64 + fr, fq * 8), boff = lds_byte(wc * 32 + fr, fq * 8);
#define PG8_SA(b, h) (((b) * 2 + (h)) * HTB)
#define PG8_SB(b, h) ((4 + (b) * 2 + (h)) * HTB)
#define PG8_STAGE(bufoff, gbase, voff) glds16_sv2((voff)[0], (voff)[1], (const char*)(gbase), lds0_ + (unsigned)(bufoff) + ldsw)
#define PG8_LDA(dst, b, h) do { _Pragma("unroll") for (int m = 0; m < 4; ++m) _Pragma("unroll") for (int k = 0; k < 2; ++k) dst[m][k] = *(const LAS bf16x8*)(lds + PG8_SA(b, h) + aoff + m * 2048 + k * 1024); } while (0)
#define PG8_LDB(dst, b, h) do { _Pragma("unroll") for (int n = 0; n < 2; ++n) _Pragma("unroll") for (int k = 0; k < 2; ++k) dst[n][k] = *(const LAS bf16x8*)(lds + PG8_SB(b, h) + boff + n * 2048 + k * 1024); } while (0)
#define PG8_MMA1(ai, bj, At, Bt) do { _Pragma("unroll") for (int m = 0; m < 4; ++m) _Pragma("unroll") for (int n = 0; n < 2; ++n) _Pragma("unroll") for (int k = 0; k < 2; ++k) \
        acc[ai][bj][m][n] = __builtin_amdgcn_mfma_f32_16x16x32_bf16(Bt[n][k], At[m][k], acc[ai][bj][m][n], 0, 0, 0); } while (0)
#define PG8_MMA2(ai, At, Bt0, Bt1) do { __builtin_amdgcn_s_setprio(1); PG8_MMA1(ai, 0, At, Bt0); PG8_MMA1(ai, 1, At, Bt1); __builtin_amdgcn_s_setprio(0); } while (0)
#define PG8_WAIT_V(n) asm volatile("s_waitcnt vmcnt(" #n ")" ::: "memory")
#define PG8_WAIT_L(n) asm volatile("s_waitcnt lgkmcnt(" #n ")" ::: "memory")
#define PG8_BAR __builtin_amdgcn_s_barrier()
#define PG8_SCHED __builtin_amdgcn_sched_barrier(0)
    Unit cur, nxt; int ui = 0;
    if (!S.next(0, cur)) return;
    f32x4 acc[2][2][4][2];
#pragma unroll
    for (int a = 0; a < 2; ++a)
#pragma unroll
        for (int b = 0; b < 2; ++b)
#pragma unroll
            for (int m = 0; m < 4; ++m)
#pragma unroll
                for (int n = 0; n < 2; ++n) acc[a][b][m][n] = (f32x4){0.f, 0.f, 0.f, 0.f};
    bf16x8 At[4][2], B0[2][2], B1[2][2];
    const char* cA = cur.a; const char* cB = cur.b;
    PG8_STAGE(PG8_SB(0, 0), cB, voffB); PG8_STAGE(PG8_SB(0, 1), cB + hstepB, voffB); PG8_STAGE(PG8_SA(0, 0), cA, vA[0]); PG8_STAGE(PG8_SA(0, 1), cA, vA[1]);
    if (wr == 1) PG8_BAR;
    PG8_WAIT_V(2); PG8_BAR;
    PG8_STAGE(PG8_SB(1, 0), cB + kstep, voffB); PG8_STAGE(PG8_SA(1, 0), cA + kstep, vA[0]); PG8_STAGE(PG8_SB(1, 1), cB + hstepB + kstep, voffB);
    PG8_WAIT_V(6); PG8_BAR;
    for (;;) {
        const bool has_next = S.next(ui + 1, nxt);
        const char* nA = has_next ? nxt.a : cA; const char* nB = has_next ? nxt.b : cB;
        if constexpr (GATHER) { if (has_next) {
#pragma unroll
            for (int i = 0; i < 2; ++i)
#pragma unroll
                for (int h = 0; h < 2; ++h) vAn[h][i] = gtab[(ui + 1) * BM + h * HALF + RA[i]] + (unsigned)CA2[i]; } }
        for (int t = 0; t < nt; t += 2) {
            const bool last = (t == nt - 2);
            unsigned sA0[2], sA1[2];
#pragma unroll
            for (int i = 0; i < 2; ++i) { if constexpr (GATHER) { sA0[i] = last ? vAn[0][i] : vA[0][i]; sA1[i] = last ? vAn[1][i] : vA[1][i]; } else { sA0[i] = vA[0][i]; sA1[i] = vA[1][i]; } }
            const char* a1 = cA + (size_t)(t + 1) * kstep;
            const char* a2 = last ? nA : cA + (size_t)(t + 2) * kstep; const char* b2 = last ? nB : cB + (size_t)(t + 2) * kstep;
            const char* a3 = a2 + kstep; const char* b3 = b2 + kstep;
            PG8_STAGE(PG8_SA(1, 1), a1, vA[1]); PG8_LDB(B0, 0, 0); PG8_LDB(B1, 0, 1); PG8_SCHED; PG8_LDA(At, 0, 0);
            PG8_WAIT_V(8); PG8_WAIT_L(0); PG8_BAR; PG8_MMA2(0, At, B0, B1); PG8_BAR; PG8_SCHED;
            PG8_STAGE(PG8_SB(0, 0), b2, voffB); PG8_STAGE(PG8_SB(0, 1), b2 + hstepB, voffB); PG8_STAGE(PG8_SA(0, 0), a2, sA0); PG8_LDA(At, 0, 1);
            PG8_WAIT_V(8); PG8_WAIT_L(0); PG8_BAR; PG8_MMA2(1, At, B0, B1); PG8_BAR; PG8_SCHED;
            PG8_STAGE(PG8_SA(0, 1), a2, sA1); PG8_LDB(B0, 1, 0); PG8_LDB(B1, 1, 1); PG8_SCHED; PG8_LDA(At, 1, 0);
            PG8_WAIT_V(8); PG8_WAIT_L(0); PG8_BAR; PG8_MMA2(0, At, B0, B1); PG8_BAR; PG8_SCHED;
            PG8_STAGE(PG8_SB(1, 0), b3, voffB); PG8_STAGE(PG8_SB(1, 1), b3 + hstepB, voffB); PG8_STAGE(PG8_SA(1, 0), a3, sA0); PG8_LDA(At, 1, 1);
            PG8_WAIT_V(8); PG8_WAIT_L(0); PG8_BAR; PG8_MMA2(1, At, B0, B1); PG8_BAR; PG8_SCHED;
        }
        if (wr == 0) PG8_BAR;
        E(acc, cur, wr, wc, fr, fq);
        if (!has_next) break;
#pragma unroll
        for (int a = 0; a < 2; ++a)
#pragma unroll
            for (int b = 0; b < 2; ++b)
#pragma unroll
                for (int m = 0; m < 4; ++m)
#pragma unroll
                    for (int n = 0; n < 2; ++n) acc[a][b][m][n] = (f32x4){0.f, 0.f, 0.f, 0.f};
        cur = nxt; cA = nA; cB = nB; ++ui;
        if constexpr (GATHER) {
#pragma unroll
            for (int i = 0; i < 2; ++i) { vA[0][i] = vAn[0][i]; vA[1][i] = vAn[1][i]; } }
        if (wr == 1) PG8_BAR;
    }
    PG8_WAIT_V(0);
    PG8_BAR;
#undef PG8_SA
#undef PG8_SB
#undef PG8_STAGE
#undef PG8_LDA
#undef PG8_LDB
#undef PG8_MMA1
#undef PG8_MMA2
#undef PG8_WAIT_V
#undef PG8_WAIT_L
#undef PG8_BAR
#undef PG8_SCHED
}

struct PlainOrder {
    int nM, nN, nwg, G, c; const char* A; const char* B; size_t a_tile, b_tile; int a_pn_split; size_t a_pn_off;
    __device__ void init(int M, int N, int G_, int c_, const void* A_, const void* B_, unsigned a_row, unsigned b_row) {
        nM = M / BM; nN = N / BM; nwg = nM * nN; G = G_; c = c_; A = (const char*)A_; B = (const char*)B_; a_tile = (size_t)BM * a_row; b_tile = (size_t)BM * b_row; a_pn_split = 1 << 30; a_pn_off = 0; }
    __device__ bool next(int i, Unit& u) const {
        const long L = (long)i * G + c; if (L >= nwg) return false;
        int wgid = (int)L; { const int q = nwg / 8, r = nwg % 8, xcd = wgid % 8, off = wgid / 8; wgid = (xcd < r ? xcd * (q + 1) : r * (q + 1) + (xcd - r) * q) + off; }
        const int nig = 8 * nN, gid = wgid / nig, fm = gid * 8, gsz = (nM - fm) < 8 ? (nM - fm) : 8;
        u.pm = fm + ((wgid % nig) % gsz); u.pn = (wgid % nig) / gsz; u.pg = 0;
        u.a = A + (size_t)u.pm * a_tile + (u.pn >= a_pn_split ? a_pn_off : 0); u.b = B + (size_t)u.pn * b_tile; return true;
    }
};
struct S5Order {
    int G, c; const char* A; const char* B; size_t a_g, a_tile, b_g; size_t a_q, b_q;
    __device__ bool next(int i, Unit& u) const {
        const int L = i * G + c; if (L >= 256) return false;
        u.pg = L >> 3; u.pm = (L >> 2) & 1; u.pn = L & 3;
        u.a = A + (size_t)u.pg * a_g + (size_t)u.pm * a_tile + (size_t)u.pn * a_q; u.b = B + (size_t)u.pg * b_g + (size_t)u.pn * b_q; return true;
    }
};
struct Moe1Order {
    int G, c; const char* A; const char* B; int e0, ne;
    __device__ bool next(int i, Unit& u) const {
        const int L = i * G + c; if (L >= ne * 256) return false;
        const int e = e0 + (L >> 8), w = L & 255, xcd = w >> 5, j = w & 31;
        const int pml = (xcd >> 1) * 4 + (j >> 3), pn = (xcd & 1) * 8 + (j & 7);
        u.pg = e; u.pm = e * 16 + pml; u.pn = pn;
        u.a = A; u.b = B + (size_t)e * (4096u * 2048u) + (size_t)pn * (256u * 2048u); return true;
    }
};
struct Moe2Order {
    int G, c; const char* A; const char* B; int e0, ne;
    __device__ bool next(int i, Unit& u) const {
        const int L = i * G + c; if (L >= ne * 64) return false;
        const int e = e0 + (L >> 6), w = L & 63;
        u.pg = e; u.pm = e * 16 + (w >> 2); u.pn = w & 3;
        u.a = A + (size_t)u.pm * (256u * 4096u); u.b = B + (size_t)e * (1024u * 4096u) + (size_t)u.pn * (256u * 4096u); return true;
    }
};

struct EpiBf16 {
    static constexpr bool PERM = true;
    bf16_t* O; int ldc; int split_cols; size_t split_stride;
    __device__ __forceinline__ void operator()(const f32x4 (&acc)[2][2][4][2], const Unit& u, int wr, int wc, int fr, int fq) const {
        const int row0 = u.pm * BM + wr * 64 + fr; int colt = u.pn * BM; bf16_t* base = O;
        if (split_cols) { const int t = colt / split_cols; base += (size_t)t * split_stride; colt -= t * split_cols; }
        const int col0 = colt + wc * 32 + 8 * fq;
#pragma unroll
        for (int ai = 0; ai < 2; ++ai)
#pragma unroll
            for (int m = 0; m < 4; ++m) { bf16_t* rowp = base + (size_t)(row0 + ai * HALF + m * 16) * ldc + col0;
#pragma unroll
                for (int bj = 0; bj < 2; ++bj) { const f32x4 v0 = acc[ai][bj][m][0], v1 = acc[ai][bj][m][1];
                    u32x4 w; w.x = cvt_pk_bf16(v0[0], v0[1]); w.y = cvt_pk_bf16(v0[2], v0[3]); w.z = cvt_pk_bf16(v1[0], v1[1]); w.w = cvt_pk_bf16(v1[2], v1[3]);
                    *(u32x4*)(rowp + bj * HALF) = w; } }
    }
};
struct EpiQKV {
    static constexpr bool PERM = true;
    bf16_t* O; size_t split_stride; const float* cs; const float* sn; const float* qg; const float* kg; LAS float* P;
    __device__ __forceinline__ void operator()(const f32x4 (&acc)[2][2][4][2], const Unit& u, int wr, int wc, int fr_, int fq_) const {
        int fr = fr_, fq = fq_; asm volatile("" : "+v"(fr), "+v"(fq));
        const int row0 = u.pm * BM + wr * 64 + fr; const int t = u.pn >> 2; const int colt = (u.pn & 3) * BM; bf16_t* base = O + (size_t)t * split_stride;
        const int col0 = colt + wc * 32 + 8 * fq;
        if (t < 2) {
            const int i0 = 16 * (wc & 1) + 4 * fq;
            f32x4 c4a[8], s4a[8];
#pragma unroll
            for (int ai = 0; ai < 2; ++ai)
#pragma unroll
                for (int m = 0; m < 4; ++m) { const int row = row0 + ai * HALF + m * 16; c4a[ai * 4 + m] = *(const f32x4*)(cs + (size_t)row * 32 + i0); s4a[ai * 4 + m] = *(const f32x4*)(sn + (size_t)row * 32 + i0); }
#pragma unroll
            for (int ai = 0; ai < 2; ++ai)
#pragma unroll
                for (int m = 0; m < 4; ++m) {
#pragma unroll
                    for (int bj = 0; bj < 2; ++bj) { const f32x4 v0 = acc[ai][bj][m][0], v1 = acc[ai][bj][m][1];
                        float sq = (v0[0] * v0[0] + v0[1] * v0[1]) + (v0[2] * v0[2] + v0[3] * v0[3]) + (v1[0] * v1[0] + v1[1] * v1[1]) + (v1[2] * v1[2] + v1[3] * v1[3]);
                        sq += __shfl_xor(sq, 16); sq += __shfl_xor(sq, 32);
                        if (fq == 0) P[(ai * HALF + wr * 64 + m * 16 + fr) * 8 + bj * 4 + wc] = sq; }
                    asm volatile("" ::: "memory"); }
            asm volatile("s_waitcnt lgkmcnt(0)" ::: "memory"); __builtin_amdgcn_s_barrier(); asm volatile("" ::: "memory");
            const float* g = t ? kg : qg; const float sc = t ? 1.0f : QSCALE;
            const f32x4 g1 = *(const f32x4*)(g + i0) * sc, g2 = *(const f32x4*)(g + 32 + i0) * sc;
#pragma unroll
            for (int ai = 0; ai < 2; ++ai)
#pragma unroll
                for (int m = 0; m < 4; ++m) { const int rl = ai * HALF + wr * 64 + m * 16 + fr; const int row = row0 + ai * HALF + m * 16; bf16_t* rowp = base + (size_t)row * 1024 + col0;
                    const f32x4 c4 = c4a[ai * 4 + m], s4 = s4a[ai * 4 + m];
#pragma unroll
                    for (int bj = 0; bj < 2; ++bj) { const f32x4 v0 = acc[ai][bj][m][0], v1 = acc[ai][bj][m][1];
                        const float tot = P[rl * 8 + bj * 4 + wc] + P[rl * 8 + bj * 4 + (wc ^ 1)]; const float rstd = __builtin_amdgcn_rsqf(tot * (1.0f / 64.0f) + EPS);
                        const float a0 = v0[0] * rstd * g1[0], b0 = v0[1] * rstd * g2[0], a1 = v0[2] * rstd * g1[1], b1 = v0[3] * rstd * g2[1];
                        const float a2 = v1[0] * rstd * g1[2], b2 = v1[1] * rstd * g2[2], a3 = v1[2] * rstd * g1[3], b3 = v1[3] * rstd * g2[3];
                        u32x4 w; w.x = cvt_pk_bf16(a0 * c4[0] - b0 * s4[0], a0 * s4[0] + b0 * c4[0]); w.y = cvt_pk_bf16(a1 * c4[1] - b1 * s4[1], a1 * s4[1] + b1 * c4[1]);
                        w.z = cvt_pk_bf16(a2 * c4[2] - b2 * s4[2], a2 * s4[2] + b2 * c4[2]); w.w = cvt_pk_bf16(a3 * c4[3] - b3 * s4[3], a3 * s4[3] + b3 * c4[3]);
                        *(u32x4*)(rowp + bj * HALF) = w; }
                    asm volatile("" ::: "memory"); }
        } else {
            __builtin_amdgcn_s_barrier();
#pragma unroll
            for (int ai = 0; ai < 2; ++ai)
#pragma unroll
                for (int m = 0; m < 4; ++m) { bf16_t* rowp = base + (size_t)(row0 + ai * HALF + m * 16) * 1024 + col0;
#pragma unroll
                    for (int bj = 0; bj < 2; ++bj) { const f32x4 v0 = acc[ai][bj][m][0], v1 = acc[ai][bj][m][1];
                        u32x4 w; w.x = cvt_pk_bf16(v0[0], v0[1]); w.y = cvt_pk_bf16(v0[2], v0[3]); w.z = cvt_pk_bf16(v1[0], v1[1]); w.w = cvt_pk_bf16(v1[2], v1[3]);
                        *(u32x4*)(rowp + bj * HALF) = w; } }
        }
    }
};
struct EpiZ {
    static constexpr bool PERM = true;
    bf16_t* zs5; bf16_t* zp;
    __device__ __forceinline__ void operator()(const f32x4 (&acc)[2][2][4][2], const Unit& u, int wr, int wc, int fr, int fq) const {
        const int row0 = u.pm * BM + wr * 64 + fr;
#pragma unroll
        for (int ai = 0; ai < 2; ++ai)
#pragma unroll
            for (int m = 0; m < 4; ++m) { const int row = row0 + ai * HALF + m * 16;
#pragma unroll
                for (int bj = 0; bj < 2; ++bj) { const f32x4 v0 = acc[ai][bj][m][0], v1 = acc[ai][bj][m][1];
                    u32x4 w; w.x = cvt_pk_bf16(v0[0], v0[1]); w.y = cvt_pk_bf16(v0[2], v0[3]); w.z = cvt_pk_bf16(v1[0], v1[1]); w.w = cvt_pk_bf16(v1[2], v1[3]);
                    const int col = u.pn * BM + bj * HALF + wc * 32 + 8 * fq;
                    if (u.pn < 2) { const int g = col >> 4, c = col & 15, R = row >> 6, i = row & 63;
                        *(u32x4*)(zs5 + ((size_t)(g * 512 + R) * 1280 + i * 16 + c)) = w; }
                    else *(u32x4*)(zp + (size_t)row * 512 + (col - 512)) = w; } }
    }
};
struct EpiState {
    static constexpr bool PERM = false;
    float* C;
    __device__ __forceinline__ void operator()(const f32x4 (&acc)[2][2][4][2], const Unit& u, int wr, int wc, int fr, int fq) const {
        float* Cb = C + ((size_t)(u.pn * 512 + u.pm * BM) * 32 + u.pg) * 256;
        const size_t off0 = (size_t)(wr * 64 + fr) * 8192 + (size_t)(wc * 32 + 4 * fq);
#pragma unroll
        for (int ai = 0; ai < 2; ++ai)
#pragma unroll
            for (int m = 0; m < 4; ++m) { float* rowp = Cb + off0 + (size_t)(ai * HALF + m * 16) * 8192;
#pragma unroll
                for (int bj = 0; bj < 2; ++bj)
#pragma unroll
                    for (int n = 0; n < 2; ++n) *(f32x4*)(rowp + bj * HALF + n * 16) = acc[ai][bj][m][n];
                asm volatile("" ::: "memory"); }
    }
};
struct EpiS5 {
    static constexpr bool PERM = true;
    const bf16_t* zs5; const float* dskip; bf16_t* YC;
    __device__ __forceinline__ void operator()(const f32x4 (&acc)[2][2][4][2], const Unit& u, int wr, int wc, int fr, int fq) const {
        const int row0 = u.pm * BM + wr * 64 + fr;
#pragma unroll
        for (int bj = 0; bj < 2; ++bj) { const int n0 = u.pn * BM + bj * HALF + wc * 32 + 8 * fq; const int ch = u.pg * 16 + (n0 & 15);
            const f32x4 d0 = *(const f32x4*)(dskip + ch), d1 = *(const f32x4*)(dskip + ch + 4);
#pragma unroll
            for (int ai = 0; ai < 2; ++ai)
#pragma unroll
                for (int m = 0; m < 4; ++m) { const int R = row0 + ai * HALF + m * 16;
                    const u32x4 uu = *(const u32x4*)(zs5 + ((size_t)(u.pg * 512 + R) * 1280 + n0));
                    const f32x4 v0 = acc[ai][bj][m][0], v1 = acc[ai][bj][m][1];
                    float y[8];
                    y[0] = d0[0] * bf_lo(uu.x) + v0[0]; y[1] = d0[1] * bf_hi(uu.x) + v0[1]; y[2] = d0[2] * bf_lo(uu.y) + v0[2]; y[3] = d0[3] * bf_hi(uu.y) + v0[3];
                    y[4] = d1[0] * bf_lo(uu.z) + v1[0]; y[5] = d1[1] * bf_hi(uu.z) + v1[1]; y[6] = d1[2] * bf_lo(uu.w) + v1[2]; y[7] = d1[3] * bf_hi(uu.w) + v1[3];
#pragma unroll
                    for (int q = 0; q < 8; ++q) y[q] = gelu_tanh(y[q]);
                    u32x4 w; w.x = cvt_pk_bf16(y[0], y[1]); w.y = cvt_pk_bf16(y[2], y[3]); w.z = cvt_pk_bf16(y[4], y[5]); w.w = cvt_pk_bf16(y[6], y[7]);
                    const int tok = R * 64 + (n0 >> 4);
                    *(u32x4*)(YC + (size_t)tok * 1024 + ch) = w; } }
    }
};
struct EpiGluPool {
    static constexpr bool PERM = true;
    const bf16_t* YC; const float* bglu; const float* pscale; bf16_t* MIX;
    __device__ __forceinline__ void operator()(const f32x4 (&acc)[2][2][4][2], const Unit& u, int wr, int wc, int fr, int fq) const {
        const int row0 = u.pm * BM + wr * 64 + fr;
#pragma unroll
        for (int bj = 0; bj < 2; ++bj) { const int col = u.pn * BM + bj * HALF + wc * 32 + 8 * fq;
            const float* vec = (u.pn < 2) ? (bglu + col) : (pscale + (col - 512));
            const f32x4 c0 = *(const f32x4*)vec, c1 = *(const f32x4*)(vec + 4);
#pragma unroll
            for (int ai = 0; ai < 2; ++ai)
#pragma unroll
                for (int m = 0; m < 4; ++m) { const int row = row0 + ai * HALF + m * 16;
                    const f32x4 v0 = acc[ai][bj][m][0], v1 = acc[ai][bj][m][1]; float o[8];
                    if (u.pn < 2) { const u32x4 yy = *(const u32x4*)(YC + (size_t)row * 1024 + col);
                        o[0] = bf_lo(yy.x) * sigmoidf_fast(v0[0] + c0[0]); o[1] = bf_hi(yy.x) * sigmoidf_fast(v0[1] + c0[1]); o[2] = bf_lo(yy.y) * sigmoidf_fast(v0[2] + c0[2]); o[3] = bf_hi(yy.y) * sigmoidf_fast(v0[3] + c0[3]);
                        o[4] = bf_lo(yy.z) * sigmoidf_fast(v1[0] + c1[0]); o[5] = bf_hi(yy.z) * sigmoidf_fast(v1[1] + c1[1]); o[6] = bf_lo(yy.w) * sigmoidf_fast(v1[2] + c1[2]); o[7] = bf_hi(yy.w) * sigmoidf_fast(v1[3] + c1[3]); }
                    else { o[0] = v0[0] * c0[0]; o[1] = v0[1] * c0[1]; o[2] = v0[2] * c0[2]; o[3] = v0[3] * c0[3]; o[4] = v1[0] * c1[0]; o[5] = v1[1] * c1[1]; o[6] = v1[2] * c1[2]; o[7] = v1[3] * c1[3]; }
                    u32x4 w; w.x = cvt_pk_bf16(o[0], o[1]); w.y = cvt_pk_bf16(o[2], o[3]); w.z = cvt_pk_bf16(o[4], o[5]); w.w = cvt_pk_bf16(o[6], o[7]);
                    *(u32x4*)(MIX + (size_t)row * 1024 + col) = w; } }
    }
};
struct EpiRes {
    static constexpr bool PERM = false;
    const float* base; float* out;
    __device__ __forceinline__ void operator()(const f32x4 (&acc)[2][2][4][2], const Unit& u, int wr, int wc, int fr, int fq) const {
        const int row0 = u.pm * BM + wr * 64 + fr, col0 = u.pn * BM + wc * 32 + 4 * fq;
#pragma unroll
        for (int ai = 0; ai < 2; ++ai)
#pragma unroll
            for (int m = 0; m < 4; ++m) { const size_t off = (size_t)(row0 + ai * HALF + m * 16) * 1024 + col0;
#pragma unroll
                for (int bj = 0; bj < 2; ++bj)
#pragma unroll
                    for (int n = 0; n < 2; ++n) { const f32x4 bs = *(const f32x4*)(base + off + bj * HALF + n * 16); *(f32x4*)(out + off + bj * HALF + n * 16) = bs + acc[ai][bj][m][n]; } }
    }
};
struct EpiResB {
    static constexpr bool PERM = true;
    const float* xin; const bf16_t* hin; bf16_t* out;
    __device__ __forceinline__ void operator()(const f32x4 (&acc)[2][2][4][2], const Unit& u, int wr, int wc, int fr, int fq) const {
        const int row0 = u.pm * BM + wr * 64 + fr, col0 = u.pn * BM + wc * 32 + 8 * fq;
#pragma unroll
        for (int ai = 0; ai < 2; ++ai)
#pragma unroll
            for (int m = 0; m < 4; ++m) { const size_t off = (size_t)(row0 + ai * HALF + m * 16) * 1024 + col0;
#pragma unroll
                for (int bj = 0; bj < 2; ++bj) { f32x4 v0 = acc[ai][bj][m][0], v1 = acc[ai][bj][m][1];
                    if (xin) { v0 += *(const f32x4*)(xin + off + bj * HALF); v1 += *(const f32x4*)(xin + off + bj * HALF + 4); }
                    else { const u32x4 w = *(const u32x4*)(hin + off + bj * HALF);
                        v0[0] += bf_lo(w.x); v0[1] += bf_hi(w.x); v0[2] += bf_lo(w.y); v0[3] += bf_hi(w.y); v1[0] += bf_lo(w.z); v1[1] += bf_hi(w.z); v1[2] += bf_lo(w.w); v1[3] += bf_hi(w.w); }
                    u32x4 o; o.x = cvt_pk_bf16(v0[0], v0[1]); o.y = cvt_pk_bf16(v0[2], v0[3]); o.z = cvt_pk_bf16(v1[0], v1[1]); o.w = cvt_pk_bf16(v1[2], v1[3]);
                    *(u32x4*)(out + off + bj * HALF) = o; } }
    }
};
struct EpiSwiglu {
    static constexpr bool PERM = true;
    bf16_t* Hm; const LAS float* rt;
    __device__ __forceinline__ void operator()(const f32x4 (&acc)[2][2][4][2], const Unit& u, int wr, int wc, int fr_, int fq_) const {
        int fr = fr_, fq = fq_; asm volatile("" : "+v"(fr), "+v"(fq));
        const int row0 = u.pm * BM + wr * 64 + fr, col0 = u.pn * HALF + wc * 32 + 8 * fq; const LAS float* rtu = rt + (u.pg & 7) * 256 + wr * 64 + fr;
#pragma unroll
        for (int ai = 0; ai < 2; ++ai)
#pragma unroll
            for (int m = 0; m < 4; ++m) { const float rs = rtu[ai * HALF + m * 16], rsn = rs * -LOG2E, rs2 = rs * rs;
                float p[8], t[8];
#pragma unroll
                for (int q = 0; q < 8; ++q) { const float g = acc[ai][0][m][q >> 2][q & 3], up = acc[ai][1][m][q >> 2][q & 3]; t[q] = g * rsn; p[q] = (g * up) * rs2; }
                __builtin_amdgcn_sched_barrier(0);
#pragma unroll
                for (int q = 0; q < 8; ++q) t[q] = fast_exp2(t[q]);
                __builtin_amdgcn_sched_barrier(0);
#pragma unroll
                for (int q = 0; q < 8; ++q) t[q] = 1.0f + t[q];
                __builtin_amdgcn_sched_barrier(0);
#pragma unroll
                for (int q = 0; q < 8; ++q) t[q] = fast_rcp(t[q]);
                __builtin_amdgcn_sched_barrier(0);
#pragma unroll
                for (int q = 0; q < 8; ++q) p[q] *= t[q];
                __builtin_amdgcn_sched_barrier(0);
                u32x4 w; w.x = cvt_pk_bf16(p[0], p[1]); w.y = cvt_pk_bf16(p[2], p[3]); w.z = cvt_pk_bf16(p[4], p[5]); w.w = cvt_pk_bf16(p[6], p[7]);
                *(u32x4*)(Hm + (size_t)(row0 + ai * HALF + m * 16) * 2048 + col0) = w; }
    }
};
struct EpiGate {
    static constexpr bool PERM = true;
    bf16_t* Y; const float* gate;
    __device__ __forceinline__ void operator()(const f32x4 (&acc)[2][2][4][2], const Unit& u, int wr, int wc, int fr, int fq) const {
        const int row0 = u.pm * BM + wr * 64 + fr, col0 = u.pn * BM + wc * 32 + 8 * fq;
#pragma unroll
        for (int ai = 0; ai < 2; ++ai)
#pragma unroll
            for (int m = 0; m < 4; ++m) { const int row = row0 + ai * HALF + m * 16; const float gt = gate[row];
#pragma unroll
                for (int bj = 0; bj < 2; ++bj) { const f32x4 v0 = acc[ai][bj][m][0] * gt, v1 = acc[ai][bj][m][1] * gt;
                    u32x4 w; w.x = cvt_pk_bf16(v0[0], v0[1]); w.y = cvt_pk_bf16(v0[2], v0[3]); w.z = cvt_pk_bf16(v1[0], v1[1]); w.w = cvt_pk_bf16(v1[2], v1[3]);
                    *(u32x4*)(Y + (size_t)row * 1024 + col0 + bj * HALF) = w; } }
    }
};
}

namespace att {
constexpr int KVBLK = 64, SHM_V = 16384, SHM_K = 16384;
#define KSWZ(row, colB) ((row) * 256 + ((colB) ^ (((row) & 15) << 4)))
#define SBAR() __builtin_amdgcn_sched_barrier(0)
__device__ __forceinline__ int crow(int r, int hi) { return (r & 3) + 8 * (r >> 2) + 4 * hi; }
__device__ __forceinline__ int v_st(int k, int c) { const int kk = (k & ~0xC) | ((k & 4) << 1) | ((k & 8) >> 1); return ((kk >> 3) * 4 + (c >> 5)) * 512 + ((kk & 7) * 32 + (c & 31)) * 2; }
__device__ __forceinline__ int v_rd_base(int lane) { return ((lane & 3) << 3) | (((lane >> 2) & 3) << 6) | (((lane >> 4) & 1) << 5) | (((lane >> 5) & 1) << 8); }
constexpr int v_rd_off(int d0, int ks, int half) { return d0 * 512 + ks * 4096 + half * 2048; }
template <int OFF> __device__ __forceinline__ s16x4 tr_read(int vb) {
    s16x4 r; asm volatile("ds_read_b64_tr_b16 %0, %1 offset:%2" : "=&v"(r) : "v"(vb), "i"(OFF) : "memory"); return r;
}
#define PK4(P, BASE, OUT) do { unsigned a0_ = cvt_pk_bf16(P[BASE + 0], P[BASE + 1]), a1_ = cvt_pk_bf16(P[BASE + 2], P[BASE + 3]);   \
    unsigned b0_ = cvt_pk_bf16(P[BASE + 4], P[BASE + 5]), b1_ = cvt_pk_bf16(P[BASE + 6], P[BASE + 7]);                              \
    auto r0_ = __builtin_amdgcn_permlane32_swap(a0_, b0_, false, false); auto r1_ = __builtin_amdgcn_permlane32_swap(a1_, b1_, false, false); \
    u32x4 w_ = {r0_[0], r1_[0], r0_[1], r1_[1]}; OUT = *reinterpret_cast<bf16x8*>(&w_); } while (0)
__device__ __forceinline__ void qk_pack(f32x16& n0, f32x16& n1, const f32x16& c0, const f32x16& c1, bf16x8& pa0, bf16x8& pa1, bf16x8& pa2, bf16x8& pa3,
                                        const LAS char* Ks, const bf16x8* qr, int r32, int hi, int map) {
    n0 = f32x16{}; n1 = f32x16{};
#pragma unroll
    for (int h = 0; h < 2; ++h) {
        bf16x8 kb[4];
#pragma unroll
        for (int t = 0; t < 2; ++t) { const int cb = (map * 64 + (2 * h + t) * 16 + hi * 8) * 2;
            kb[2 * t] = *(const LAS bf16x8*)(Ks + KSWZ(r32, cb)); kb[2 * t + 1] = *(const LAS bf16x8*)(Ks + KSWZ(32 + r32, cb)); }
        SBAR();
        if (h == 0) { PK4(c0, 0, pa0); PK4(c0, 8, pa1); } else { PK4(c1, 0, pa2); PK4(c1, 8, pa3); }
        SBAR();
        __builtin_amdgcn_s_setprio(1);
#pragma unroll
        for (int t = 0; t < 2; ++t) { n0 = __builtin_amdgcn_mfma_f32_32x32x16_bf16(kb[2 * t], qr[2 * h + t], n0, 0, 0, 0); n1 = __builtin_amdgcn_mfma_f32_32x32x16_bf16(kb[2 * t + 1], qr[2 * h + t], n1, 0, 0, 0); }
        __builtin_amdgcn_s_setprio(0);
        SBAR();
    }
}
template <int D0> __device__ __forceinline__ void pv_exp_one(f32x16& od, int vb, bf16x8 pa0, bf16x8 pa1, bf16x8 pa2, bf16x8 pa3, f32x16& n0, f32x16& n1) {
    const s16x4 l0 = tr_read<v_rd_off(D0, 0, 0)>(vb), h0 = tr_read<v_rd_off(D0, 0, 1)>(vb), l1 = tr_read<v_rd_off(D0, 1, 0)>(vb), h1 = tr_read<v_rd_off(D0, 1, 1)>(vb);
    const s16x4 l2 = tr_read<v_rd_off(D0, 2, 0)>(vb), h2 = tr_read<v_rd_off(D0, 2, 1)>(vb), l3 = tr_read<v_rd_off(D0, 3, 0)>(vb), h3 = tr_read<v_rd_off(D0, 3, 1)>(vb);
    SBAR();
#pragma unroll
    for (int r = 4 * D0; r < 4 * D0 + 4; ++r) { n0[r] = __builtin_amdgcn_exp2f(n0[r]); n1[r] = __builtin_amdgcn_exp2f(n1[r]); }
    SBAR();
    asm volatile("s_waitcnt lgkmcnt(0)" ::: "memory"); SBAR();
#define PK(L, H) (bf16x8){L[0], L[1], L[2], L[3], H[0], H[1], H[2], H[3]}
    __builtin_amdgcn_s_setprio(1);
    od = __builtin_amdgcn_mfma_f32_32x32x16_bf16(pa0, PK(l0, h0), od, 0, 0, 0);
    od = __builtin_amdgcn_mfma_f32_32x32x16_bf16(pa1, PK(l1, h1), od, 0, 0, 0);
    od = __builtin_amdgcn_mfma_f32_32x32x16_bf16(pa2, PK(l2, h2), od, 0, 0, 0);
    od = __builtin_amdgcn_mfma_f32_32x32x16_bf16(pa3, PK(l3, h3), od, 0, 0, 0);
    __builtin_amdgcn_s_setprio(0);
    SBAR();
#undef PK
}
__device__ __forceinline__ void psum(f32x16& osum, bf16x8 pa0, bf16x8 pa1, bf16x8 pa2, bf16x8 pa3) {
    const bf16x8 ones = {0x3F80, 0x3F80, 0x3F80, 0x3F80, 0x3F80, 0x3F80, 0x3F80, 0x3F80};
    osum = __builtin_amdgcn_mfma_f32_32x32x16_bf16(pa0, ones, osum, 0, 0, 0); osum = __builtin_amdgcn_mfma_f32_32x32x16_bf16(pa1, ones, osum, 0, 0, 0);
    osum = __builtin_amdgcn_mfma_f32_32x32x16_bf16(pa2, ones, osum, 0, 0, 0); osum = __builtin_amdgcn_mfma_f32_32x32x16_bf16(pa3, ones, osum, 0, 0, 0);
}
__device__ __forceinline__ void pv_exp(f32x16* o, f32x16& osum, int vb, bf16x8 pa0, bf16x8 pa1, bf16x8 pa2, bf16x8 pa3, f32x16& n0, f32x16& n1) {
    pv_exp_one<0>(o[0], vb, pa0, pa1, pa2, pa3, n0, n1); pv_exp_one<1>(o[1], vb, pa0, pa1, pa2, pa3, n0, n1);
    pv_exp_one<2>(o[2], vb, pa0, pa1, pa2, pa3, n0, n1); pv_exp_one<3>(o[3], vb, pa0, pa1, pa2, pa3, n0, n1);
    psum(osum, pa0, pa1, pa2, pa3); SBAR();
}
template <int D0> __device__ __forceinline__ void pv_one(f32x16& od, int vb, bf16x8 pa0, bf16x8 pa1, bf16x8 pa2, bf16x8 pa3) {
    const s16x4 l0 = tr_read<v_rd_off(D0, 0, 0)>(vb), h0 = tr_read<v_rd_off(D0, 0, 1)>(vb), l1 = tr_read<v_rd_off(D0, 1, 0)>(vb), h1 = tr_read<v_rd_off(D0, 1, 1)>(vb);
    const s16x4 l2 = tr_read<v_rd_off(D0, 2, 0)>(vb), h2 = tr_read<v_rd_off(D0, 2, 1)>(vb), l3 = tr_read<v_rd_off(D0, 3, 0)>(vb), h3 = tr_read<v_rd_off(D0, 3, 1)>(vb);
    asm volatile("s_waitcnt lgkmcnt(0)" ::: "memory"); SBAR();
#define PK(L, H) (bf16x8){L[0], L[1], L[2], L[3], H[0], H[1], H[2], H[3]}
    od = __builtin_amdgcn_mfma_f32_32x32x16_bf16(pa0, PK(l0, h0), od, 0, 0, 0);
    od = __builtin_amdgcn_mfma_f32_32x32x16_bf16(pa1, PK(l1, h1), od, 0, 0, 0);
    od = __builtin_amdgcn_mfma_f32_32x32x16_bf16(pa2, PK(l2, h2), od, 0, 0, 0);
    od = __builtin_amdgcn_mfma_f32_32x32x16_bf16(pa3, PK(l3, h3), od, 0, 0, 0);
#undef PK
}
__device__ __forceinline__ void pv_d0(f32x16* o, int vb, bf16x8 pa0, bf16x8 pa1, bf16x8 pa2, bf16x8 pa3) {
    pv_one<0>(o[0], vb, pa0, pa1, pa2, pa3); pv_one<1>(o[1], vb, pa0, pa1, pa2, pa3); pv_one<2>(o[2], vb, pa0, pa1, pa2, pa3); pv_one<3>(o[3], vb, pa0, pa1, pa2, pa3);
}
__device__ __forceinline__ void qkt(f32x16& p0, f32x16& p1, const LAS char* Ks, const bf16x8* qr, int r32, int hi, int map) {
    p0 = f32x16{}; p1 = f32x16{};
#pragma unroll
    for (int d0 = 0; d0 < 4; ++d0) { const int cb = (map * 64 + d0 * 16 + hi * 8) * 2;
        const bf16x8 b0 = *(const LAS bf16x8*)(Ks + KSWZ(r32, cb));
        const bf16x8 b1 = *(const LAS bf16x8*)(Ks + KSWZ(32 + r32, cb));
        p0 = __builtin_amdgcn_mfma_f32_32x32x16_bf16(b0, qr[d0], p0, 0, 0, 0);
        p1 = __builtin_amdgcn_mfma_f32_32x32x16_bf16(b1, qr[d0], p1, 0, 0, 0); }
}
__device__ __forceinline__ void exp_all(f32x16& p0, f32x16& p1) {
#pragma unroll
    for (int r = 0; r < 16; ++r) { p0[r] = __builtin_amdgcn_exp2f(p0[r]); p1[r] = __builtin_amdgcn_exp2f(p1[r]); }
}
__device__ __forceinline__ void glds16(const void* gsrc, unsigned lds_dst) {
    asm volatile("s_mov_b32 m0, %1\n\ts_nop 0\n\tglobal_load_lds_dwordx4 %0, off" : : "v"(gsrc), "s"(lds_dst) : "memory", "m0"); }
__device__ __forceinline__ void glds16s(unsigned voff, const char* sbase, unsigned lds_dst) {
    asm volatile("s_mov_b32 m0, %2\n\ts_nop 0\n\tglobal_load_lds_dwordx4 %0, %1" : : "v"(voff), "s"(sbase), "s"(lds_dst) : "memory", "m0"); }
__device__ __forceinline__ void glds4(unsigned k0, unsigned k1, unsigned v0, unsigned v1, const char* kbase, const char* vbase, unsigned lds_dst) {
    asm volatile("s_mov_b32 m0, %6\n\ts_nop 0\n\tglobal_load_lds_dwordx4 %0, %4\n\tglobal_load_lds_dwordx4 %1, %4 offset:1024\n\tglobal_load_lds_dwordx4 %2, %5 offset:2048\n\tglobal_load_lds_dwordx4 %3, %5 offset:3072"
                 : : "v"(k0), "v"(k1), "v"(v0), "v"(v1), "s"(kbase), "s"(vbase), "s"(lds_dst) : "memory", "m0"); }
__device__ __forceinline__ void glds_m0(unsigned lds_dst) { asm volatile("s_mov_b32 m0, %0\n\ts_nop 0" : : "s"(lds_dst) : "memory", "m0"); }
template <int OFF> __device__ __forceinline__ void glds_o(unsigned voff, const char* sbase) { asm volatile("global_load_lds_dwordx4 %0, %1 offset:%2" : : "v"(voff), "s"(sbase), "i"(OFF) : "memory"); }
constexpr int SLOTB = 32768, NSLOT = 3;
__device__ __forceinline__ void attn_unit(LAS unsigned char* lds, const bf16_t* __restrict__ Q, const bf16_t* __restrict__ K, const bf16_t* __restrict__ V, bf16_t* __restrict__ O,
                                          int b, int h, int qb, float lam, float osc, const float* __restrict__ subg) {
    int tid_ = threadIdx.x; asm volatile("" : "+v"(tid_));
    const int tid = tid_, wid = __builtin_amdgcn_readfirstlane(tid >> 6), lane = tid & 63, r32 = lane & 31, hi = lane >> 5;
    const int map = wid & 1, rg = wid >> 1;
    const unsigned lds0 = (unsigned)(size_t)lds;
    LAS float* wsf = (LAS float*)(lds + NSLOT * SLOTB) + wid * 64;
    const long rowbase = (long)b * SEQ;
    const bf16_t* Qw = Q + (rowbase + qb * 128 + rg * 32 + r32) * 1024 + h * 128 + map * 64 + hi * 8;
    bf16x8 qr[4];
#pragma unroll
    for (int d0 = 0; d0 < 4; ++d0) qr[d0] = *(const bf16x8*)(Qw + d0 * 16);
    const char* Kt = (const char*)(K + rowbase * 1024 + h * 128); const char* Vt = (const char*)(V + rowbase * 1024 + h * 128);
    unsigned koff[2], voff[2];
#pragma unroll
    for (int i = 0; i < 2; ++i) { const int p = 2 * wid + i;
        const int row = 4 * p + (lane >> 4), chunk = (lane & 15) ^ (row & 15); koff[i] = (unsigned)(row * 2048 + chunk * 16);
        const int kk = (p >> 1) * 8 + ((lane & 31) >> 2), c = (2 * (p & 1) + (lane >> 5)) * 32 + (lane & 3) * 8, k = (kk & ~0xC) | ((kk & 4) << 1) | ((kk & 8) >> 1);
        voff[i] = (unsigned)(k * 2048 + c * 2); }
#define DMA(t, slot) do { const char* kb_ = Kt + (size_t)(t) * (64 * 2048); const char* vb_ = Vt + (size_t)(t) * (64 * 2048); const unsigned sb_ = lds0 + (unsigned)(slot) * SLOTB + (unsigned)wid * 2048u; \
    glds16(kb_ + koff[0], sb_); glds16(kb_ + koff[1], sb_ + 1024u); glds16(vb_ + voff[0], sb_ + 16384u); glds16(vb_ + voff[1], sb_ + 16384u + 1024u); } while (0)
#define WAIT_BAR(N) asm volatile("s_waitcnt vmcnt(" #N ") lgkmcnt(0)\n\ts_barrier" ::: "memory")
    float l_reg = 0.f; f32x16 o[4] = {};
    unsigned kad[4];
#pragma unroll
    for (int d0 = 0; d0 < 4; ++d0) kad[d0] = (unsigned)KSWZ(r32, (map * 64 + d0 * 16 + hi * 8) * 2);
    f32x16 pA0, pA1, pB0, pB1; bf16x8 pa0, pa1, pa2, pa3; constexpr int NT = SEQ / KVBLK;
    const int vrb = (int)lds0 + 16384 + v_rd_base(lane);
    DMA(0, 0); DMA(1, 1);
    WAIT_BAR(4);
    qkt(pA0, pA1, (const LAS char*)lds, qr, r32, hi, map); exp_all(pA0, pA1);
    { float t_ = 0.f;
#pragma unroll
      for (int r = 0; r < 16; ++r) t_ += pA0[r] + pA1[r];
      l_reg += t_; }
    int s_cur = 0, s_nxt = 1, s_nn = 2;
#define KRD(dst, addr, off) asm volatile("ds_read_b128 %0, %1 offset:%2" : "=&v"(dst) : "v"(addr), "i"(off) : "memory")
#define TRD(dst, addr, off) asm volatile("ds_read_b64_tr_b16 %0, %1 offset:%2" : "=&v"(dst) : "v"(addr), "i"(off) : "memory")
#define LWT(n) asm volatile("s_waitcnt lgkmcnt(" #n ")" ::: "memory")
#define PKV(L, H) (bf16x8){L[0], L[1], L[2], L[3], H[0], H[1], H[2], H[3]}
#define DEFERRED() do { \
        o[3] = __builtin_amdgcn_mfma_f32_32x32x16_bf16(pa0, PKV(vc[0], vc[1]), o[3], 0, 0, 0); o[3] = __builtin_amdgcn_mfma_f32_32x32x16_bf16(pa1, PKV(vc[2], vc[3]), o[3], 0, 0, 0); \
        o[3] = __builtin_amdgcn_mfma_f32_32x32x16_bf16(pa2, PKV(vc[4], vc[5]), o[3], 0, 0, 0); o[3] = __builtin_amdgcn_mfma_f32_32x32x16_bf16(pa3, PKV(vc[6], vc[7]), o[3], 0, 0, 0); } while (0)
#define ITER(j, C0, C1, N0, N1, DEFER) do { \
        WAIT_BAR(0);                                                     \
        { const unsigned kb_ = lds0 + (unsigned)s_nxt * SLOTB; const int vb_ = vrb + s_cur * SLOTB; \
          const bool dma_ = (j) + 2 < NT; const char* dk_ = Kt + (size_t)((j) + 2) * (64 * 2048); const char* dv_ = Vt + (size_t)((j) + 2) * (64 * 2048); const unsigned ds_ = lds0 + (unsigned)s_nn * SLOTB + (unsigned)wid * 2048u; \
          bf16x8 kq0, kq1, kq2, kq3; float sA_ = 0.f, sB_ = 0.f; \
          KRD(kq0, kb_ + kad[0], 0); \
          KRD(kq1, kb_ + kad[0], 8192); \
          KRD(kq2, kb_ + kad[1], 0); \
          KRD(kq3, kb_ + kad[1], 8192); \
          SBAR(); \
          if (DEFER) { \
            o[3] = __builtin_amdgcn_mfma_f32_32x32x16_bf16(pa0, PKV(vc[0], vc[1]), o[3], 0, 0, 0); SBAR(); C1[6] = __builtin_amdgcn_exp2f(C1[6]); sA_ += C1[6]; C1[7] = __builtin_amdgcn_exp2f(C1[7]); sB_ += C1[7]; SBAR(); \
            o[3] = __builtin_amdgcn_mfma_f32_32x32x16_bf16(pa1, PKV(vc[2], vc[3]), o[3], 0, 0, 0); SBAR(); C1[8] = __builtin_amdgcn_exp2f(C1[8]); sA_ += C1[8]; C1[9] = __builtin_amdgcn_exp2f(C1[9]); sB_ += C1[9]; SBAR(); \
            o[3] = __builtin_amdgcn_mfma_f32_32x32x16_bf16(pa2, PKV(vc[4], vc[5]), o[3], 0, 0, 0); SBAR(); C1[10] = __builtin_amdgcn_exp2f(C1[10]); sA_ += C1[10]; C1[11] = __builtin_amdgcn_exp2f(C1[11]); sB_ += C1[11]; SBAR(); \
            o[3] = __builtin_amdgcn_mfma_f32_32x32x16_bf16(pa3, PKV(vc[6], vc[7]), o[3], 0, 0, 0); SBAR(); C1[12] = __builtin_amdgcn_exp2f(C1[12]); sA_ += C1[12]; C1[13] = __builtin_amdgcn_exp2f(C1[13]); sB_ += C1[13]; SBAR(); \
          } \
          N0 = f32x16{}; N1 = f32x16{}; \
          LWT(3); SBAR(); N0 = __builtin_amdgcn_mfma_f32_32x32x16_bf16(kq0, qr[0], N0, 0, 0, 0); SBAR(); \
          if (dma_) glds16(dk_ + koff[0], ds_); \
          if (DEFER) { C1[14] = __builtin_amdgcn_exp2f(C1[14]); sA_ += C1[14]; C1[15] = __builtin_amdgcn_exp2f(C1[15]); sB_ += C1[15]; } \
          KRD(kq0, kb_ + kad[2], 0); \
          SBAR(); \
          LWT(3); SBAR(); N1 = __builtin_amdgcn_mfma_f32_32x32x16_bf16(kq1, qr[0], N1, 0, 0, 0); SBAR(); \
          if (dma_) glds16(dk_ + koff[1], ds_ + 1024u); \
          PK4(C0, 0, pa0); \
          KRD(kq1, kb_ + kad[2], 8192); \
          SBAR(); \
          LWT(3); SBAR(); N0 = __builtin_amdgcn_mfma_f32_32x32x16_bf16(kq2, qr[1], N0, 0, 0, 0); SBAR(); \
          if (dma_) glds16(dv_ + voff[0], ds_ + 16384u); \
          PK4(C0, 8, pa1); \
          KRD(kq2, kb_ + kad[3], 0); \
          TRD(va[0], vb_, v_rd_off(0, 0, 0)); TRD(va[1], vb_, v_rd_off(0, 0, 1)); \
          SBAR(); \
          LWT(5); SBAR(); N1 = __builtin_amdgcn_mfma_f32_32x32x16_bf16(kq3, qr[1], N1, 0, 0, 0); SBAR(); \
          if (dma_) glds16(dv_ + voff[1], ds_ + 16384u + 1024u); \
          KRD(kq3, kb_ + kad[3], 8192); \
          TRD(va[2], vb_, v_rd_off(0, 1, 0)); TRD(va[3], vb_, v_rd_off(0, 1, 1)); \
          SBAR(); \
          LWT(7); SBAR(); N0 = __builtin_amdgcn_mfma_f32_32x32x16_bf16(kq0, qr[2], N0, 0, 0, 0); SBAR(); \
          PK4(C1, 0, pa2); \
          TRD(va[4], vb_, v_rd_off(0, 2, 0)); TRD(va[5], vb_, v_rd_off(0, 2, 1)); \
          SBAR(); \
          LWT(8); SBAR(); N1 = __builtin_amdgcn_mfma_f32_32x32x16_bf16(kq1, qr[2], N1, 0, 0, 0); SBAR(); \
          PK4(C1, 8, pa3); \
          TRD(va[6], vb_, v_rd_off(0, 3, 0)); TRD(va[7], vb_, v_rd_off(0, 3, 1)); \
          SBAR(); \
          LWT(9); SBAR(); N0 = __builtin_amdgcn_mfma_f32_32x32x16_bf16(kq2, qr[3], N0, 0, 0, 0); SBAR(); \
          TRD(vc[0], vb_, v_rd_off(1, 0, 0)); TRD(vc[1], vb_, v_rd_off(1, 0, 1)); \
          SBAR(); \
          LWT(8); SBAR(); N1 = __builtin_amdgcn_mfma_f32_32x32x16_bf16(kq3, qr[3], N1, 0, 0, 0); SBAR(); \
          TRD(vc[2], vb_, v_rd_off(1, 1, 0)); TRD(vc[3], vb_, v_rd_off(1, 1, 1)); \
          SBAR(); \
          LWT(11); SBAR(); o[0] = __builtin_amdgcn_mfma_f32_32x32x16_bf16(pa0, PKV(va[0], va[1]), o[0], 0, 0, 0); SBAR(); \
          TRD(vc[4], vb_, v_rd_off(1, 2, 0)); TRD(vc[5], vb_, v_rd_off(1, 2, 1)); \
          SBAR(); \
          LWT(10); SBAR(); o[0] = __builtin_amdgcn_mfma_f32_32x32x16_bf16(pa1, PKV(va[2], va[3]), o[0], 0, 0, 0); SBAR(); \
          TRD(vc[6], vb_, v_rd_off(1, 3, 0)); TRD(vc[7], vb_, v_rd_off(1, 3, 1)); \
          N0[0] = __builtin_amdgcn_exp2f(N0[0]); sA_ += N0[0]; N0[1] = __builtin_amdgcn_exp2f(N0[1]); sB_ += N0[1]; \
          SBAR(); \
          LWT(10); SBAR(); o[0] = __builtin_amdgcn_mfma_f32_32x32x16_bf16(pa2, PKV(va[4], va[5]), o[0], 0, 0, 0); SBAR(); \
          TRD(va[0], vb_, v_rd_off(2, 0, 0)); TRD(va[1], vb_, v_rd_off(2, 0, 1)); \
          N0[2] = __builtin_amdgcn_exp2f(N0[2]); sA_ += N0[2]; N0[3] = __builtin_amdgcn_exp2f(N0[3]); sB_ += N0[3]; \
          SBAR(); \
          LWT(10); SBAR(); o[0] = __builtin_amdgcn_mfma_f32_32x32x16_bf16(pa3, PKV(va[6], va[7]), o[0], 0, 0, 0); SBAR(); \
          TRD(va[2], vb_, v_rd_off(2, 1, 0)); TRD(va[3], vb_, v_rd_off(2, 1, 1)); \
          N0[4] = __builtin_amdgcn_exp2f(N0[4]); sA_ += N0[4]; N0[5] = __builtin_amdgcn_exp2f(N0[5]); sB_ += N0[5]; \
          SBAR(); \
          LWT(10); SBAR(); o[1] = __builtin_amdgcn_mfma_f32_32x32x16_bf16(pa0, PKV(vc[0], vc[1]), o[1], 0, 0, 0); SBAR(); \
          TRD(va[4], vb_, v_rd_off(2, 2, 0)); TRD(va[5], vb_, v_rd_off(2, 2, 1)); \
          N0[6] = __builtin_amdgcn_exp2f(N0[6]); sA_ += N0[6]; N0[7] = __builtin_amdgcn_exp2f(N0[7]); sB_ += N0[7]; \
          SBAR(); \
          LWT(10); SBAR(); o[1] = __builtin_amdgcn_mfma_f32_32x32x16_bf16(pa1, PKV(vc[2], vc[3]), o[1], 0, 0, 0); SBAR(); \
          TRD(va[6], vb_, v_rd_off(2, 3, 0)); TRD(va[7], vb_, v_rd_off(2, 3, 1)); \
          N0[8] = __builtin_amdgcn_exp2f(N0[8]); sA_ += N0[8]; N0[9] = __builtin_amdgcn_exp2f(N0[9]); sB_ += N0[9]; \
          SBAR(); \
          LWT(10); SBAR(); o[1] = __builtin_amdgcn_mfma_f32_32x32x16_bf16(pa2, PKV(vc[4], vc[5]), o[1], 0, 0, 0); SBAR(); \
          TRD(vc[0], vb_, v_rd_off(3, 0, 0)); TRD(vc[1], vb_, v_rd_off(3, 0, 1)); \
          N0[10] = __builtin_amdgcn_exp2f(N0[10]); sA_ += N0[10]; N0[11] = __builtin_amdgcn_exp2f(N0[11]); sB_ += N0[11]; \
          SBAR(); \
          LWT(10); SBAR(); o[1] = __builtin_amdgcn_mfma_f32_32x32x16_bf16(pa3, PKV(vc[6], vc[7]), o[1], 0, 0, 0); SBAR(); \
          TRD(vc[2], vb_, v_rd_off(3, 1, 0)); TRD(vc[3], vb_, v_rd_off(3, 1, 1)); \
          N0[12] = __builtin_amdgcn_exp2f(N0[12]); sA_ += N0[12]; N0[13] = __builtin_amdgcn_exp2f(N0[13]); sB_ += N0[13]; \
          SBAR(); \
          LWT(10); SBAR(); o[2] = __builtin_amdgcn_mfma_f32_32x32x16_bf16(pa0, PKV(va[0], va[1]), o[2], 0, 0, 0); SBAR(); \
          TRD(vc[4], vb_, v_rd_off(3, 2, 0)); TRD(vc[5], vb_, v_rd_off(3, 2, 1)); \
          N0[14] = __builtin_amdgcn_exp2f(N0[14]); sA_ += N0[14]; N0[15] = __builtin_amdgcn_exp2f(N0[15]); sB_ += N0[15]; \
          SBAR(); \
          LWT(10); SBAR(); o[2] = __builtin_amdgcn_mfma_f32_32x32x16_bf16(pa1, PKV(va[2], va[3]), o[2], 0, 0, 0); SBAR(); \
          TRD(vc[6], vb_, v_rd_off(3, 3, 0)); TRD(vc[7], vb_, v_rd_off(3, 3, 1)); \
          N1[0] = __builtin_amdgcn_exp2f(N1[0]); sA_ += N1[0]; N1[1] = __builtin_amdgcn_exp2f(N1[1]); sB_ += N1[1]; \
          SBAR(); \
          LWT(10); SBAR(); o[2] = __builtin_amdgcn_mfma_f32_32x32x16_bf16(pa2, PKV(va[4], va[5]), o[2], 0, 0, 0); SBAR(); \
          N1[2] = __builtin_amdgcn_exp2f(N1[2]); sA_ += N1[2]; N1[3] = __builtin_amdgcn_exp2f(N1[3]); sB_ += N1[3]; \
          SBAR(); \
          LWT(8); SBAR(); o[2] = __builtin_amdgcn_mfma_f32_32x32x16_bf16(pa3, PKV(va[6], va[7]), o[2], 0, 0, 0); SBAR(); \
          N1[4] = __builtin_amdgcn_exp2f(N1[4]); sA_ += N1[4]; N1[5] = __builtin_amdgcn_exp2f(N1[5]); sB_ += N1[5]; \
          SBAR(); \
          l_reg += sA_ + sB_; LWT(0); } \
        { const int t_ = s_cur; s_cur = s_nxt; s_nxt = s_nn; s_nn = t_; } } while (0)
    s16x4 va[8], vc[8];
    if (wid >= 4) __builtin_amdgcn_s_setprio(1);
    ITER(0, pA0, pA1, pB0, pB1, false); ITER(1, pB0, pB1, pA0, pA1, true);
    for (int jj = 2; jj < NT - 2; jj += 2) { ITER(jj, pA0, pA1, pB0, pB1, true); ITER(jj + 1, pB0, pB1, pA0, pA1, true); }
    ITER(NT - 2, pA0, pA1, pB0, pB1, true);
    DEFERRED(); SBAR();
    __builtin_amdgcn_s_setprio(0);
    { float sA_ = 0.f, sB_ = 0.f;
#pragma unroll
      for (int e = 22; e < 32; ++e) { pB1[e - 16] = __builtin_amdgcn_exp2f(pB1[e - 16]); sA_ += pB1[e - 16]; }
      l_reg += sA_ + sB_; }
    PK4(pB0, 0, pa0); PK4(pB0, 8, pa1); PK4(pB1, 0, pa2); PK4(pB1, 8, pa3); SBAR();
    pv_d0(o, vrb + s_cur * SLOTB, pa0, pa1, pa2, pa3);
#undef DEFERRED
#undef ITER
#undef KRD
#undef TRD
#undef LWT
#undef PKV
#undef DMA
    float lt = l_reg; { auto rr = __builtin_amdgcn_permlane32_swap(__float_as_uint(lt), __float_as_uint(lt), false, false); lt = __uint_as_float(rr[0]) + __uint_as_float(rr[1]); }
    if (hi == 0) wsf[r32] = lt;
    asm volatile("s_waitcnt lgkmcnt(0)" ::: "memory");
    const float msc = map ? lam : 1.0f;
#pragma unroll
    for (int r = 0; r < 16; ++r) { const float rl = __builtin_amdgcn_rcpf(wsf[crow(r, hi)]) * msc;
#pragma unroll
        for (int d0 = 0; d0 < 4; ++d0) o[d0][r] *= rl; }
    WAIT_BAR(0);
    LAS float* X = (LAS float*)lds + rg * 4096;
    if (map == 1) {
#pragma unroll
        for (int r = 0; r < 16; ++r)
#pragma unroll
            for (int d0 = 0; d0 < 4; ++d0) X[crow(r, hi) * 128 + 32 * d0 + r32] = o[d0][r];
    }
    WAIT_BAR(0);
    if (map == 0) {
        float sg[4];
#pragma unroll
        for (int d0 = 0; d0 < 4; ++d0) sg[d0] = subg[32 * d0 + r32] * osc;
        bf16_t* Ow = O + (rowbase + qb * 128 + rg * 32) * 1024 + h * 128 + r32;
#pragma unroll
        for (int r = 0; r < 16; ++r) { float ss = 0.f;
#pragma unroll
            for (int d0 = 0; d0 < 4; ++d0) { o[d0][r] -= X[crow(r, hi) * 128 + 32 * d0 + r32]; ss += o[d0][r] * o[d0][r]; }
            ss += __shfl_xor(ss, 1); ss += __shfl_xor(ss, 2); ss += __shfl_xor(ss, 4); ss += __shfl_xor(ss, 8); ss += __shfl_xor(ss, 16);
            const float rs = __builtin_amdgcn_rsqf(ss * (1.0f / 128.0f) + EPS);
#pragma unroll
            for (int d0 = 0; d0 < 4; ++d0) Ow[(long)crow(r, hi) * 1024 + 32 * d0] = (bf16_t)f2bf(o[d0][r] * rs * sg[d0]); }
    }
    WAIT_BAR(0);
#undef WAIT_BAR
}

typedef short v4i16_t __attribute__((ext_vector_type(4)));
#define VTR(p) __builtin_bit_cast(s16x4, __builtin_amdgcn_ds_read_tr16_b64_v4i16((LAS v4i16_t*)(p)))
#define MF16(a, b, c) __builtin_amdgcn_mfma_f32_16x16x32_bf16(a, b, c, 0, 0, 0)
#define PK2(X, Y, OUT) do { u32x4 w_ = {cvt_pk_bf16(X[0], X[1]), cvt_pk_bf16(X[2], X[3]), cvt_pk_bf16(Y[0], Y[1]), cvt_pk_bf16(Y[2], Y[3])}; OUT = *reinterpret_cast<bf16x8*>(&w_); } while (0)
#define KRD(dst, addr, off) asm volatile("ds_read_b128 %0, %1 offset:%2" : "=&v"(dst) : "v"(addr), "i"(off) : "memory")
#define TRD(dst, addr, off) asm volatile("ds_read_b64_tr_b16 %0, %1 offset:%2" : "=&v"(dst) : "v"(addr), "i"(off) : "memory")
#define LWT(n) asm volatile("s_waitcnt lgkmcnt(" #n ")" ::: "memory")
#define PKV(L, H) (bf16x8){L[0], L[1], L[2], L[3], H[0], H[1], H[2], H[3]}
#define FADD(acc, x) ((acc) += (x))
#define WAIT_BAR(N) asm volatile("s_waitcnt vmcnt(" #N ") lgkmcnt(0)\n\ts_barrier" ::: "memory")
#define LBAR() asm volatile("s_waitcnt lgkmcnt(0)\n\ts_barrier" ::: "memory")
__device__ __forceinline__ void attn_unit16(LAS unsigned char* lds, const bf16_t* __restrict__ Q, const bf16_t* __restrict__ K, const bf16_t* __restrict__ V, bf16_t* __restrict__ O,
                                            int b, int h, int qb, float lam, float osc, const float* __restrict__ subg, bf16x8 (&qr)[2][2], bool first, bool has_next, int nb, int nh) {
    int tid_ = threadIdx.x; asm volatile("" : "+v"(tid_));
    const int tid = tid_, wid = __builtin_amdgcn_readfirstlane(tid >> 6), lane = tid & 63, t16 = lane & 15, rq = lane >> 4;
    const int map = wid & 1, rg = wid >> 1;
    const unsigned lds0 = (unsigned)(size_t)lds;
    LAS float* wsf = (LAS float*)(lds + NSLOT * SLOTB) + wid * 64;
    const long rowbase = (long)b * SEQ;
    if (first) {
#pragma unroll
        for (int hh = 0; hh < 2; ++hh)
#pragma unroll
            for (int ds = 0; ds < 2; ++ds) qr[hh][ds] = *(const bf16x8*)(Q + (rowbase + qb * 128 + rg * 32 + 16 * hh + t16) * 1024 + h * 128 + map * 64 + 32 * ds + 8 * rq); }
    const char* Kt = (const char*)(K + rowbase * 1024 + h * 128); const char* Vt = (const char*)(V + rowbase * 1024 + h * 128);
    unsigned koff[2], voff[2];
#pragma unroll
    for (int i = 0; i < 2; ++i) { const int p = 2 * wid + i;
        const int row = 4 * p + (lane >> 4), chunk = (lane & 15) ^ (row & 15); koff[i] = (unsigned)(row * 2048 + chunk * 16) - (i ? 1024u : 0u);
        const int key = 16 * (p & 3) + (lane >> 2), c = lane & 3, col = (p >> 2) * 32 + (((c >> 1) ^ ((key >> 2) & 1)) * 16) + (c & 1) * 8;
        voff[i] = (unsigned)(key * 2048 + col * 2) + (i ? 0u : 1024u); }
#define DMA(t, slot) DMAX(Kt, Vt, t, slot)
#define DMAX(KT_, VT_, t, slot) do { const char* kb_ = (KT_) + (size_t)(t) * (64 * 2048); const char* vb_ = (VT_) + (size_t)(t) * (64 * 2048); const unsigned sb_ = lds0 + (unsigned)(slot) * SLOTB + (unsigned)wid * 4096u; \
    glds4(koff[0], koff[1], voff[0], voff[1], kb_, vb_ - 3072, sb_); } while (0)
    unsigned kad[2];
#pragma unroll
    for (int ds = 0; ds < 2; ++ds) kad[ds] = (unsigned)((t16 >> 3) * 4096 + ((t16 >> 2) & 1) * 1024 + (t16 & 3) * 256 + ((map * 128 + ds * 64 + rq * 16) ^ (t16 << 4)));
    const unsigned vbe = (unsigned)((4 * rq + (t16 >> 2)) * 64 + (t16 & 3) * 8 + (rq & 1) * 32), vbo = (unsigned)((4 * rq + (t16 >> 2)) * 64 + (t16 & 3) * 8 + ((rq & 1) ^ 1) * 32);
    f32x4 ls0 = {0.f, 0.f, 0.f, 0.f}, ls1 = {0.f, 0.f, 0.f, 0.f}; f32x4 o[2][8];
    bf16x8 ones_ = {0x3F80, 0x3F80, 0x3F80, 0x3F80, 0x3F80, 0x3F80, 0x3F80, 0x3F80}; asm volatile("" : "+v"(ones_));
#pragma unroll
    for (int hh = 0; hh < 2; ++hh)
#pragma unroll
        for (int cb = 0; cb < 8; ++cb) o[hh][cb] = (f32x4){0.f, 0.f, 0.f, 0.f};
    f32x4 pA[2][4], pB[2][4]; bf16x8 pa00, pa01, pa10, pa11; s16x4 vf[8][2]; constexpr int NT = SEQ / KVBLK;
    const f32x4 z4_ = {0.f, 0.f, 0.f, 0.f};
    if (first) { DMA(0, 0); DMA(1, 1); }
    WAIT_BAR(0);
    {
#pragma unroll
        for (int kb = 0; kb < 4; ++kb) { const bf16x8 k0 = *(const LAS bf16x8*)(lds + kad[0] + kb * 8192), k1 = *(const LAS bf16x8*)(lds + kad[1] + kb * 8192);
#pragma unroll
            for (int hh = 0; hh < 2; ++hh) { f32x4 sacc = MF16(k0, qr[hh][0], z4_); sacc = MF16(k1, qr[hh][1], sacc);
#pragma unroll
                for (int r = 0; r < 4; ++r) { sacc[r] = __builtin_amdgcn_exp2f(sacc[r]); }
                pA[hh][kb] = sacc; } }
    }
    asm volatile("s_nop 1" ::: "memory"); PK2(pA[0][0], pA[0][1], pa00); PK2(pA[1][0], pA[1][1], pa10);
    __builtin_amdgcn_s_setprio(1);
#define ITER(j, C, N, SC, SN, SNN, DMA_) do { \
        WAIT_BAR(0); \
        { const LAS unsigned char* kp_ = lds + (SN) * SLOTB; const LAS unsigned char* ve_ = lds + ((SC) * SLOTB + 2048) + vbe; const LAS unsigned char* vo_ = lds + ((SC) * SLOTB + 2048) + vbo; \
          constexpr bool dma_ = DMA_; const char* dk_ = Kt + (size_t)((j) + 2) * (64 * 2048); const char* dv_ = Vt + (size_t)((j) + 2) * (64 * 2048); const unsigned ds_ = lds0 + (unsigned)(SNN) * SLOTB + (unsigned)wid * 4096u; \
          bf16x8 kq0, kq1, kq2, kq3, kq4, kq5, kq6, kq7; \
          kq0 = *(const LAS bf16x8*)(kp_ + kad[0] + 0); \
          kq1 = *(const LAS bf16x8*)(kp_ + kad[1] + 0); \
          kq2 = *(const LAS bf16x8*)(kp_ + kad[0] + 8192); \
          kq3 = *(const LAS bf16x8*)(kp_ + kad[1] + 8192); \
          SBAR(); \
          SBAR(); N[0][0] = MF16(kq0, qr[0][0], z4_); N[1][0] = MF16(kq0, qr[1][0], z4_); SBAR(); \
          if constexpr (dma_) { glds_m0(ds_); glds_o<0>(koff[0], dk_); } \
          kq4 = *(const LAS bf16x8*)(kp_ + kad[0] + 16384); \
          SBAR(); \
          SBAR(); N[0][0] = MF16(kq1, qr[0][1], N[0][0]); N[1][0] = MF16(kq1, qr[1][1], N[1][0]); SBAR(); \
          if constexpr (dma_) glds_o<1024>(koff[1], dk_); \
          kq5 = *(const LAS bf16x8*)(kp_ + kad[1] + 16384); \
          SBAR(); \
          SBAR(); N[0][1] = MF16(kq2, qr[0][0], z4_); N[1][1] = MF16(kq2, qr[1][0], z4_); SBAR(); \
          if constexpr (dma_) glds_o<2048>(voff[0], dv_ - 3072); \
          kq6 = *(const LAS bf16x8*)(kp_ + kad[0] + 24576); \
          SBAR(); \
          SBAR(); N[0][1] = MF16(kq3, qr[0][1], N[0][1]); N[1][1] = MF16(kq3, qr[1][1], N[1][1]); SBAR(); \
          if constexpr (dma_) glds_o<3072>(voff[1], dv_ - 3072); \
          kq7 = *(const LAS bf16x8*)(kp_ + kad[1] + 24576); \
          SBAR(); \
          SBAR(); N[0][2] = MF16(kq4, qr[0][0], z4_); N[1][2] = MF16(kq4, qr[1][0], z4_); SBAR(); \
          PK2(C[0][2], C[0][3], pa01); \
          vf[0][0] = VTR(ve_ + 0); vf[0][1] = VTR(ve_ + 1024); \
          SBAR(); \
          SBAR(); N[0][2] = MF16(kq5, qr[0][1], N[0][2]); N[1][2] = MF16(kq5, qr[1][1], N[1][2]); SBAR(); \
          PK2(C[1][2], C[1][3], pa11); \
          vf[1][0] = VTR(vo_ + 0); vf[1][1] = VTR(vo_ + 1024); \
          SBAR(); \
          SBAR(); N[0][3] = MF16(kq6, qr[0][0], z4_); N[1][3] = MF16(kq6, qr[1][0], z4_); SBAR(); \
          vf[2][0] = VTR(ve_ + 8192); vf[2][1] = VTR(ve_ + 9216); \
          SBAR(); \
          SBAR(); N[0][3] = MF16(kq7, qr[0][1], N[0][3]); N[1][3] = MF16(kq7, qr[1][1], N[1][3]); SBAR(); \
          vf[3][0] = VTR(vo_ + 8192); vf[3][1] = VTR(vo_ + 9216); \
          SBAR(); \
          SBAR(); o[0][0] = MF16(pa00, PKV(vf[0][0], vf[0][1]), o[0][0]); o[1][0] = MF16(pa10, PKV(vf[0][0], vf[0][1]), o[1][0]); SBAR(); \
          vf[4][0] = VTR(ve_ + 16384); vf[4][1] = VTR(ve_ + 17408); \
          SBAR(); \
          SBAR(); o[0][1] = MF16(pa00, PKV(vf[1][0], vf[1][1]), o[0][1]); o[1][1] = MF16(pa10, PKV(vf[1][0], vf[1][1]), o[1][1]); SBAR(); \
          vf[5][0] = VTR(vo_ + 16384); vf[5][1] = VTR(vo_ + 17408); \
          SBAR(); \
          SBAR(); o[0][2] = MF16(pa00, PKV(vf[2][0], vf[2][1]), o[0][2]); o[1][2] = MF16(pa10, PKV(vf[2][0], vf[2][1]), o[1][2]); SBAR(); \
          vf[6][0] = VTR(ve_ + 24576); vf[6][1] = VTR(ve_ + 25600); \
          SBAR(); \
          SBAR(); o[0][3] = MF16(pa00, PKV(vf[3][0], vf[3][1]), o[0][3]); o[1][3] = MF16(pa10, PKV(vf[3][0], vf[3][1]), o[1][3]); SBAR(); \
          vf[7][0] = VTR(vo_ + 24576); vf[7][1] = VTR(vo_ + 25600); \
          SBAR(); \
          SBAR(); o[0][4] = MF16(pa00, PKV(vf[4][0], vf[4][1]), o[0][4]); o[1][4] = MF16(pa10, PKV(vf[4][0], vf[4][1]), o[1][4]); SBAR(); \
          vf[0][0] = VTR(ve_ + 4096); vf[0][1] = VTR(ve_ + 5120); \
          SBAR(); \
          SBAR(); o[0][5] = MF16(pa00, PKV(vf[5][0], vf[5][1]), o[0][5]); o[1][5] = MF16(pa10, PKV(vf[5][0], vf[5][1]), o[1][5]); SBAR(); \
          vf[1][0] = VTR(vo_ + 4096); vf[1][1] = VTR(vo_ + 5120); \
          SBAR(); \
          SBAR(); o[0][6] = MF16(pa00, PKV(vf[6][0], vf[6][1]), o[0][6]); o[1][6] = MF16(pa10, PKV(vf[6][0], vf[6][1]), o[1][6]); SBAR(); \
          vf[2][0] = VTR(ve_ + 12288); vf[2][1] = VTR(ve_ + 13312); \
          SBAR(); \
          SBAR(); o[0][7] = MF16(pa00, PKV(vf[7][0], vf[7][1]), o[0][7]); o[1][7] = MF16(pa10, PKV(vf[7][0], vf[7][1]), o[1][7]); ls0 = MF16(pa00, ones_, ls0); ls1 = MF16(pa10, ones_, ls1); SBAR(); \
          vf[3][0] = VTR(vo_ + 12288); vf[3][1] = VTR(vo_ + 13312); \
          SBAR(); \
          SBAR(); __builtin_amdgcn_s_setprio(0); \
          N[0][0][0] = __builtin_amdgcn_exp2f(N[0][0][0]); N[0][0][1] = __builtin_amdgcn_exp2f(N[0][0][1]); N[0][0][2] = __builtin_amdgcn_exp2f(N[0][0][2]); N[0][0][3] = __builtin_amdgcn_exp2f(N[0][0][3]); \
          N[0][1][0] = __builtin_amdgcn_exp2f(N[0][1][0]); N[0][1][1] = __builtin_amdgcn_exp2f(N[0][1][1]); N[0][1][2] = __builtin_amdgcn_exp2f(N[0][1][2]); N[0][1][3] = __builtin_amdgcn_exp2f(N[0][1][3]); \
          N[1][0][0] = __builtin_amdgcn_exp2f(N[1][0][0]); N[1][0][1] = __builtin_amdgcn_exp2f(N[1][0][1]); N[1][0][2] = __builtin_amdgcn_exp2f(N[1][0][2]); N[1][0][3] = __builtin_amdgcn_exp2f(N[1][0][3]); \
          N[1][1][0] = __builtin_amdgcn_exp2f(N[1][1][0]); N[1][1][1] = __builtin_amdgcn_exp2f(N[1][1][1]); N[1][1][2] = __builtin_amdgcn_exp2f(N[1][1][2]); N[1][1][3] = __builtin_amdgcn_exp2f(N[1][1][3]); \
          SBAR(); \
          N[0][2][0] = __builtin_amdgcn_exp2f(N[0][2][0]); N[0][2][1] = __builtin_amdgcn_exp2f(N[0][2][1]); N[0][2][2] = __builtin_amdgcn_exp2f(N[0][2][2]); N[0][2][3] = __builtin_amdgcn_exp2f(N[0][2][3]); \
          N[0][3][0] = __builtin_amdgcn_exp2f(N[0][3][0]); N[0][3][1] = __builtin_amdgcn_exp2f(N[0][3][1]); N[0][3][2] = __builtin_amdgcn_exp2f(N[0][3][2]); N[0][3][3] = __builtin_amdgcn_exp2f(N[0][3][3]); \
          N[1][2][0] = __builtin_amdgcn_exp2f(N[1][2][0]); N[1][2][1] = __builtin_amdgcn_exp2f(N[1][2][1]); N[1][2][2] = __builtin_amdgcn_exp2f(N[1][2][2]); N[1][2][3] = __builtin_amdgcn_exp2f(N[1][2][3]); \
          N[1][3][0] = __builtin_amdgcn_exp2f(N[1][3][0]); N[1][3][1] = __builtin_amdgcn_exp2f(N[1][3][1]); N[1][3][2] = __builtin_amdgcn_exp2f(N[1][3][2]); N[1][3][3] = __builtin_amdgcn_exp2f(N[1][3][3]); \
          SBAR(); \
          PK2(N[0][0], N[0][1], pa00); PK2(N[1][0], N[1][1], pa10); \
          __builtin_amdgcn_s_setprio(1); SBAR(); \
          SBAR(); o[0][0] = MF16(pa01, PKV(vf[0][0], vf[0][1]), o[0][0]); o[1][0] = MF16(pa11, PKV(vf[0][0], vf[0][1]), o[1][0]); SBAR(); \
          vf[4][0] = VTR(ve_ + 20480); vf[4][1] = VTR(ve_ + 21504); \
          SBAR(); \
          SBAR(); o[0][1] = MF16(pa01, PKV(vf[1][0], vf[1][1]), o[0][1]); o[1][1] = MF16(pa11, PKV(vf[1][0], vf[1][1]), o[1][1]); SBAR(); \
          vf[5][0] = VTR(vo_ + 20480); vf[5][1] = VTR(vo_ + 21504); \
          SBAR(); \
          SBAR(); o[0][2] = MF16(pa01, PKV(vf[2][0], vf[2][1]), o[0][2]); o[1][2] = MF16(pa11, PKV(vf[2][0], vf[2][1]), o[1][2]); SBAR(); \
          vf[6][0] = VTR(ve_ + 28672); vf[6][1] = VTR(ve_ + 29696); \
          SBAR(); \
          SBAR(); o[0][3] = MF16(pa01, PKV(vf[3][0], vf[3][1]), o[0][3]); o[1][3] = MF16(pa11, PKV(vf[3][0], vf[3][1]), o[1][3]); SBAR(); \
          vf[7][0] = VTR(vo_ + 28672); vf[7][1] = VTR(vo_ + 29696); \
          SBAR(); \
          SBAR(); o[0][4] = MF16(pa01, PKV(vf[4][0], vf[4][1]), o[0][4]); o[1][4] = MF16(pa11, PKV(vf[4][0], vf[4][1]), o[1][4]); SBAR(); \
          SBAR(); \
          SBAR(); o[0][5] = MF16(pa01, PKV(vf[5][0], vf[5][1]), o[0][5]); o[1][5] = MF16(pa11, PKV(vf[5][0], vf[5][1]), o[1][5]); SBAR(); \
          SBAR(); \
          SBAR(); o[0][6] = MF16(pa01, PKV(vf[6][0], vf[6][1]), o[0][6]); o[1][6] = MF16(pa11, PKV(vf[6][0], vf[6][1]), o[1][6]); SBAR(); \
          SBAR(); \
          SBAR(); o[0][7] = MF16(pa01, PKV(vf[7][0], vf[7][1]), o[0][7]); o[1][7] = MF16(pa11, PKV(vf[7][0], vf[7][1]), o[1][7]); ls0 = MF16(pa01, ones_, ls0); ls1 = MF16(pa11, ones_, ls1); SBAR(); \
          SBAR(); \
          } \
        } while (0)
    static_assert((NT - 1) % 6 == 3 && (NT - 1) % 3 == 0, "tile count");
    for (int jj = 0; jj < NT - 4; jj += 6) {
        ITER(jj, pA, pB, 0, 1, 2, true); ITER(jj + 1, pB, pA, 1, 2, 0, true); ITER(jj + 2, pA, pB, 2, 0, 1, true);
        ITER(jj + 3, pB, pA, 0, 1, 2, true); ITER(jj + 4, pA, pB, 1, 2, 0, true); ITER(jj + 5, pB, pA, 2, 0, 1, true); }
    ITER(NT - 4, pA, pB, 0, 1, 2, true); ITER(NT - 3, pB, pA, 1, 2, 0, true); ITER(NT - 2, pA, pB, 2, 0, 1, false);
    SBAR();
    PK2(pB[0][0], pB[0][1], pa00); PK2(pB[0][2], pB[0][3], pa01); PK2(pB[1][0], pB[1][1], pa10); PK2(pB[1][2], pB[1][3], pa11); SBAR();
    ls0 = MF16(pa00, ones_, ls0); ls1 = MF16(pa10, ones_, ls1); ls0 = MF16(pa01, ones_, ls0); ls1 = MF16(pa11, ones_, ls1);
    { const unsigned vb_ = lds0 + (unsigned)((NT - 1) % 3) * SLOTB + 2048u;
#pragma unroll
      for (int kg = 0; kg < 2; ++kg)
#pragma unroll
          for (int cb = 0; cb < 8; ++cb) { s16x4 f0, f1; const unsigned ad = vb_ + ((cb & 1) ? vbo : vbe) + (unsigned)(kg * 4096 + (cb >> 1) * 8192);
              asm volatile("ds_read_b64_tr_b16 %0, %1" : "=&v"(f0) : "v"(ad) : "memory"); asm volatile("ds_read_b64_tr_b16 %0, %1 offset:1024" : "=&v"(f1) : "v"(ad) : "memory");
              LWT(0); SBAR();
              o[0][cb] = MF16(kg ? pa01 : pa00, PKV(f0, f1), o[0][cb]); o[1][cb] = MF16(kg ? pa11 : pa10, PKV(f0, f1), o[1][cb]); SBAR(); } }
#undef ITER
    __builtin_amdgcn_s_setprio(0);
    const float msc = map ? lam : 1.0f;
#pragma unroll
    for (int hh = 0; hh < 2; ++hh)
#pragma unroll
        for (int r = 0; r < 4; ++r) { const float rl = __builtin_amdgcn_rcpf(hh ? ls1[r] : ls0[r]) * msc;
#pragma unroll
            for (int cb = 0; cb < 8; ++cb) o[hh][cb][r] *= rl; }
    WAIT_BAR(0);
    if (has_next) {
        const long rbn = (long)nb * SEQ;
#pragma unroll
        for (int hh = 0; hh < 2; ++hh)
#pragma unroll
            for (int ds = 0; ds < 2; ++ds) qr[hh][ds] = *(const bf16x8*)(Q + (rbn + qb * 128 + rg * 32 + 16 * hh + t16) * 1024 + nh * 128 + map * 64 + 32 * ds + 8 * rq);
        const char* Ktn = (const char*)(K + rbn * 1024 + nh * 128); const char* Vtn = (const char*)(V + rbn * 1024 + nh * 128);
        DMAX(Ktn, Vtn, 0, 0); DMAX(Ktn, Vtn, 1, 1); }
    LAS float* X = (LAS float*)(lds + (rg == 0 ? 98304 : rg == 1 ? 114688 : rg == 2 ? 133120 : 65536));
    if (map == 0) {
#pragma unroll
        for (int r = 0; r < 4; ++r)
#pragma unroll
            for (int cb = 0; cb < 8; ++cb) X[(4 * rq + r) * 128 + 16 * cb + t16] = o[1][cb][r];
    } else {
#pragma unroll
        for (int r = 0; r < 4; ++r)
#pragma unroll
            for (int cb = 0; cb < 8; ++cb) X[2048 + (4 * rq + r) * 128 + 16 * cb + t16] = o[0][cb][r];
    }
    LBAR();
    {
        float sg[8];
#pragma unroll
        for (int cb = 0; cb < 8; ++cb) sg[cb] = subg[16 * cb + t16] * osc;
        bf16_t* Ow = O + (rowbase + qb * 128 + rg * 32 + 16 * map) * 1024 + h * 128 + t16;
        const LAS float* Xr = X + (map ? 0 : 2048);
#pragma unroll
        for (int r = 0; r < 4; ++r) { const int q = 4 * rq + r; float d[8]; float ss = 0.f;
#pragma unroll
            for (int cb = 0; cb < 8; ++cb) { const float xv = Xr[q * 128 + 16 * cb + t16]; d[cb] = map ? (xv - o[1][cb][r]) : (o[0][cb][r] - xv); ss += d[cb] * d[cb]; }
            ss += __shfl_xor(ss, 1); ss += __shfl_xor(ss, 2); ss += __shfl_xor(ss, 4); ss += __shfl_xor(ss, 8);
            const float rs = __builtin_amdgcn_rsqf(ss * (1.0f / 128.0f) + EPS);
#pragma unroll
            for (int cb = 0; cb < 8; ++cb) Ow[(long)q * 1024 + 16 * cb] = (bf16_t)f2bf(d[cb] * rs * sg[cb]); }
    }
#undef DMA
#undef DMAX
}
#undef MF16
#undef PK2
#undef KRD
#undef TRD
#undef LWT
#undef PKV
#undef FADD
#undef WAIT_BAR
#undef KSWZ
#undef SBAR
}

constexpr int MOE_PREP_SEL_PER_WAVE = 3;
constexpr int MOE_PREP_HEAD = 16 * 1536 - MOE_PREP_SEL_PER_WAVE * 224 * 8;
struct Params { const void* in[31]; float* out; unsigned char* ws; };
struct Ctx { LAS unsigned char* lds; int tid, lane, wave, vcu, G, gw, NGW; };

template <class RM>
__device__ __forceinline__ void transpose_item(const float* W, int N, bf16_t* WT, int ldt, RM rm, LAS float* scr, int item, int lane) {
    const int nblk = N / 32, kb = item / nblk, nb = item % nblk, k0 = 64 * kb, n0 = 32 * nb;
    f32x4 v[8];
#pragma unroll
    for (int i = 0; i < 8; ++i) v[i] = __builtin_nontemporal_load((const f32x4*)(W + (size_t)(k0 + 8 * i + (lane >> 3)) * N + n0 + 4 * (lane & 7)));
#pragma unroll
    for (int i = 0; i < 8; ++i) { LAS float* d = scr + (8 * i + (lane >> 3)) * 33 + 4 * (lane & 7); d[0] = v[i][0]; d[1] = v[i][1]; d[2] = v[i][2]; d[3] = v[i][3]; }
    LDS_WAIT(); asm volatile("" ::: "memory");
    const int c = lane & 7;
#pragma unroll
    for (int j = 0; j < 4; ++j) { const int n = (lane >> 3) + 8 * j; const LAS float* s = scr + (8 * c) * 33 + n;
        u32x4 o; o.x = cvt_pk_bf16(s[0 * 33], s[1 * 33]); o.y = cvt_pk_bf16(s[2 * 33], s[3 * 33]); o.z = cvt_pk_bf16(s[4 * 33], s[5 * 33]); o.w = cvt_pk_bf16(s[6 * 33], s[7 * 33]);
        *(u32x4*)(WT + (size_t)rm(n0 + n) * ldt + k0 + 8 * c) = o; }
    LDS_WAIT(); asm volatile("" ::: "memory");
}
template <class RM>
__device__ __forceinline__ void transpose_item64(const float* W, int N, bf16_t* WT, int ldt, RM rm, LAS float* scr, int item, int lane, const float* gk = nullptr) {
    const int nblk = N / 64, kb = item / nblk, nb = item % nblk, k0 = 64 * kb, n0 = 64 * nb;
    f32x4 v[16];
#pragma unroll
    for (int i = 0; i < 16; ++i) v[i] = __builtin_nontemporal_load((const f32x4*)(W + (size_t)(k0 + 4 * i + (lane >> 4)) * N + n0 + 4 * (lane & 15)));
    if (gk) {
#pragma unroll
        for (int i = 0; i < 16; ++i) v[i] *= gk[k0 + 4 * i + (lane >> 4)]; }
#pragma unroll
    for (int i = 0; i < 16; ++i) { const int kk = 4 * i + (lane >> 4), c4 = 4 * (lane & 15); *(LAS f32x4*)(scr + kk * 64 + (c4 ^ (((kk >> 3) & 7) << 3))) = v[i]; }
    LDS_WAIT(); asm volatile("" ::: "memory");
    const int cb = lane & 7;
#pragma unroll
    for (int j = 0; j < 8; ++j) { const int n = (lane >> 3) + 8 * j; const LAS float* s = scr + (8 * cb) * 64 + (n ^ (cb << 3));
        u32x4 o; o.x = cvt_pk_bf16(s[0 * 64], s[1 * 64]); o.y = cvt_pk_bf16(s[2 * 64], s[3 * 64]); o.z = cvt_pk_bf16(s[4 * 64], s[5 * 64]); o.w = cvt_pk_bf16(s[6 * 64], s[7 * 64]);
        *(u32x4*)(WT + (size_t)rm(n0 + n) * ldt + k0 + 8 * cb) = o; }
    LDS_WAIT(); asm volatile("" ::: "memory");
}
struct RmId { __device__ __forceinline__ int operator()(int n) const { return n; } };
struct RmQK { __device__ __forceinline__ int operator()(int n) const { const int i = n & 63; return n < 2048 ? ((n & ~63) + (i < 32 ? 2 * i : 2 * (i - 32) + 1)) : n; } };
struct RmGate { int add; __device__ __forceinline__ int operator()(int n) const { return ((n >> 7) << 8) + add + (n & 127); } };

__device__ __forceinline__ void rms_row_to_bf16(const float* xrow, const f32x4 (&g4)[4], bf16_t* orow, int lane) {
    const f32x4* xr = (const f32x4*)xrow + lane; f32x4 v[4]; float s = 0.f;
#pragma unroll
    for (int j = 0; j < 4; ++j) { v[j] = xr[64 * j]; s += (v[j][0] * v[j][0] + v[j][1] * v[j][1]) + (v[j][2] * v[j][2] + v[j][3] * v[j][3]); }
    const float rstd = __builtin_amdgcn_rsqf(wave_sum(s) * (1.f / DM) + EPS);
    u32x2* o8 = (u32x2*)orow + lane;
#pragma unroll
    for (int j = 0; j < 4; ++j) { const f32x4 y = v[j] * rstd * g4[j]; u32x2 w; w.x = cvt_pk_bf16(y[0], y[1]); w.y = cvt_pk_bf16(y[2], y[3]); o8[64 * j] = w; }
}

__device__ __forceinline__ void moe_weight_prep(const Ctx& F, const float* wg, const float* wu, const float* wd, const float* gain, bf16_t* bt1, bf16_t* bt2, int w0, int nw, int iend = 16 * 1536) {
    LAS float* scr = (LAS float*)(F.lds + F.wave * 16384);
    for (int it = w0; it < iend; it += nw) {
        const int e = it / 1536, r = it % 1536;
        if (r < 512) transpose_item64(wg + (size_t)e * 1024 * 2048, 2048, bt1 + (size_t)e * 4096 * 1024, 1024, RmGate{0}, scr, r, F.lane, gain);
        else if (r < 1024) transpose_item64(wu + (size_t)e * 1024 * 2048, 2048, bt1 + (size_t)e * 4096 * 1024, 1024, RmGate{128}, scr, r - 512, F.lane, gain);
        else transpose_item64(wd + (size_t)e * 2048 * 1024, 1024, bt2 + (size_t)e * 1024 * 2048, 2048, RmId{}, scr, r - 1024, F.lane);
    }
}
template <class RM = RmId>
__device__ __forceinline__ void weight_prep(const Ctx& F, const float* W, int K, int N, bf16_t* WT, int w0, int nw) {
    LAS float* scr = (LAS float*)(F.lds + F.wave * 16384);
    const int items = (K / 64) * (N / 32);
    for (int it = w0; it < items; it += nw) transpose_item(W, N, WT, K, RM{}, scr, it, F.lane);
}

__device__ __forceinline__ void s5_prep1(const Ctx& F, const unsigned char* lds_raw, int ev, bf16_t* wst, bf16_t* btm, float* kbuf, float* aL) {
    const float* lam_re = (const float*)getp(lds_raw, 6) + (size_t)ev * 2 * 32 * 64; const float* lam_im = (const float*)getp(lds_raw, 7) + (size_t)ev * 2 * 32 * 64;
    const float* log_dt = (const float*)getp(lds_raw, 8) + (size_t)ev * 2 * 32;
    const float* b_re = (const float*)getp(lds_raw, 9) + (size_t)ev * 2 * 32 * 64 * 16; const float* b_im = (const float*)getp(lds_raw, 10) + (size_t)ev * 2 * 32 * 64 * 16;
    const float* c_re = (const float*)getp(lds_raw, 11) + (size_t)ev * 2 * 32 * 16 * 64; const float* c_im = (const float*)getp(lds_raw, 12) + (size_t)ev * 2 * 32 * 16 * 64;
    LAS float* AP = (LAS float*)F.lds; LAS float* BB = (LAS float*)(F.lds + 66560); LAS float* CC = (LAS float*)(F.lds + 82944);
    for (int g = F.vcu; g < 32; g += F.G) {
        __syncthreads();
        if (F.tid < 128) { const int dir = F.tid >> 6, p = F.tid & 63; const int pi = (dir * 32 + g) * 64 + p;
            const float lre = lam_re[pi], lim = lam_im[pi]; const float dt = __expf(log_dt[dir * 32 + g]);
            for (int tau = 0; tau <= 64; ++tau) { const float mag = __expf((float)tau * lre * dt); float s, c; sincos_big((double)tau * (double)lim * (double)dt, s, c);
                AP[((dir * 65 + tau) * 64 + p) * 2] = mag * c; AP[((dir * 65 + tau) * 64 + p) * 2 + 1] = mag * s; }
            float a_re, a_im; { const float mag = __expf(lre * dt); float s, c; sincos_big((double)lim * (double)dt, s, c); a_re = mag * c; a_im = mag * s; }
            const float nr = a_re - 1.0f, ni = a_im, den = 1.0f / (lre * lre + lim * lim);
            const float cr = (nr * lre + ni * lim) * den, ci = (ni * lre - nr * lim) * den;
            for (int c = 0; c < 16; ++c) { const float br = b_re[(size_t)pi * 16 + c], bi = b_im[(size_t)pi * 16 + c];
                BB[((dir * 64 + p) * 16 + c) * 2] = cr * br - ci * bi; BB[((dir * 64 + p) * 16 + c) * 2 + 1] = cr * bi + ci * br; }
        }
        for (int i = F.tid; i < 2048; i += NTHR) { const int dir = i >> 10, c = (i >> 6) & 15, p = i & 63; const size_t gi = ((size_t)(dir * 32 + g) * 16 + c) * 64 + p;
            CC[i * 2] = c_re[gi]; CC[i * 2 + 1] = c_im[gi]; }
        __syncthreads();
        if (F.tid < 128) { const int dir = F.tid >> 6, p = F.tid & 63;
            aL[((dir * 32 + g) * 64 + p) * 2] = AP[((dir * 65 + 64) * 64 + p) * 2]; aL[((dir * 32 + g) * 64 + p) * 2 + 1] = AP[((dir * 65 + 64) * 64 + p) * 2 + 1]; }
        { const int dir = F.tid >> 8, c = (F.tid >> 4) & 15, c2 = F.tid & 15; float acc[64];
#pragma unroll
            for (int t = 0; t < 64; ++t) acc[t] = 0.f;
            for (int p = 0; p < 64; ++p) { const f32x2 cv = *(const LAS f32x2*)(CC + ((dir * 16 + c) * 64 + p) * 2), bv = *(const LAS f32x2*)(BB + ((dir * 64 + p) * 16 + c2) * 2);
                const float gr = cv[0] * bv[0] - cv[1] * bv[1], gi = cv[0] * bv[1] + cv[1] * bv[0];
#pragma unroll
                for (int t = 0; t < 64; ++t) { const f32x2 av = *(const LAS f32x2*)(AP + ((dir * 65 + t) * 64 + p) * 2); acc[t] += gr * av[0] - gi * av[1]; } }
#pragma unroll
            for (int t = 0; t < 64; ++t) kbuf[(size_t)g * 32768 + (dir << 14) + (t << 8) + (c << 4) + c2] = acc[t]; }
        for (int i = F.tid; i < 256 * 1024; i += NTHR) { const int n = i >> 10, k = i & 1023, dir = n >> 7, reim = (n >> 6) & 1, p = n & 63, ti = k >> 4, c = k & 15;
            const int tau = dir ? ti : 63 - ti;
            const f32x2 av = *(const LAS f32x2*)(AP + ((dir * 65 + tau) * 64 + p) * 2), bv = *(const LAS f32x2*)(BB + ((dir * 64 + p) * 16 + c) * 2);
            const float ar = av[0], ai = av[1], br = bv[0], bi = bv[1];
            const float v = reim ? (ar * bi + ai * br) : (ar * br - ai * bi);
            wst[(size_t)g * 256 * 1024 + i] = (bf16_t)f2bf(v); }
        for (int i = F.tid; i < 1024 * 256; i += NTHR) { const int n = i >> 8, kk = i & 255, dir = kk >> 7, reim = (kk >> 6) & 1, p = kk & 63, ti = n >> 4, c = n & 15;
            const int tau = dir ? 64 - ti : ti + 1;
            const f32x2 av = *(const LAS f32x2*)(AP + ((dir * 65 + tau) * 64 + p) * 2), cv = *(const LAS f32x2*)(CC + ((dir * 16 + c) * 64 + p) * 2);
            const float ar = av[0], ai = av[1], cr = cv[0], ci = cv[1];
            const float v = reim ? -(cr * ai + ci * ar) : (cr * ar - ci * ai);
            btm[((size_t)g * 1024 + n) * 1280 + 1024 + kk] = (bf16_t)f2bf(v); }
    }
    __syncthreads();
}
__device__ __forceinline__ void s5_prep2(const Ctx& F, const float* kbuf, bf16_t* btm) {
    const int gt = F.gw * 64 + F.lane, NT = F.NGW * 64;
    for (int it = gt; it < 32 * 1024 * 128; it += NT) { const int g = it >> 17, n = (it >> 7) & 1023, k8 = it & 127, i = n >> 4, c = n & 15, i2 = k8 >> 1, c2 = (k8 & 1) * 8;
        const float* kb = kbuf + (size_t)g * 32768; float v[8];
        if (i2 < i) { const float* s = kb + ((0 * 64 + (i - i2)) * 16 + c) * 16 + c2;
#pragma unroll
            for (int q = 0; q < 8; ++q) v[q] = s[q]; }
        else if (i2 > i) { const float* s = kb + ((1 * 64 + (i2 - i)) * 16 + c) * 16 + c2;
#pragma unroll
            for (int q = 0; q < 8; ++q) v[q] = s[q]; }
        else { const float* s0 = kb + ((0 * 64 + 0) * 16 + c) * 16 + c2; const float* s1 = kb + ((1 * 64 + 0) * 16 + c) * 16 + c2;
#pragma unroll
            for (int q = 0; q < 8; ++q) v[q] = s0[q] + s1[q]; }
        u32x4 w; w.x = cvt_pk_bf16(v[0], v[1]); w.y = cvt_pk_bf16(v[2], v[3]); w.z = cvt_pk_bf16(v[4], v[5]); w.w = cvt_pk_bf16(v[6], v[7]);
        *(u32x4*)(btm + ((size_t)g * 1024 + n) * 1280 + k8 * 8) = w; }
}
__device__ __forceinline__ void glupool_prep(const Ctx& F, const float* wglu, const float* poolw, bf16_t* wgp, int w0, int nw) {
    weight_prep(F, wglu, 512, 512, wgp, w0, nw);
    const int gt = w0 * 64 + F.lane, NT = nw * 64;
    for (int it = gt; it < 512 * 512; it += NT) { const int n = it >> 9, k = it & 511, gi = n >> 7, d = n & 127;
        const float v = ((k >> 7) == gi) ? poolw[((size_t)gi * 128 + (k & 127)) * 128 + d] : 0.f;
        wgp[(size_t)(512 + n) * 512 + k] = (bf16_t)f2bf(v); }
}

__device__ __forceinline__ void pool_phase(const Ctx& F, const bf16_t* zp, bf16_t* YC, int first, int stride) {
    for (int tok = first; tok < TOK; tok += stride) { const int s = tok & (SEQ - 1), l = F.lane, gi = l >> 4, hw = 1 << gi;
        const int lo = (s - hw) < 0 ? 0 : (s - hw), hiq = (s + hw) > SEQ ? SEQ : (s + hw);
        float a[8];
#pragma unroll
        for (int q = 0; q < 8; ++q) a[q] = 0.f;
        const bf16_t* base = zp + (size_t)(tok - s) * 512 + l * 8;
        u32x4 wv[16];
#pragma unroll
        for (int d = -8; d < 8; ++d) { const int sp = s + d; const bool ok = d >= -hw && d < hw && sp >= 0 && sp < SEQ; wv[d + 8] = *(const u32x4*)(base + (size_t)(ok ? sp : s) * 512); }
#pragma unroll
        for (int d = -8; d < 8; ++d) { const int sp = s + d; const bool ok = d >= -hw && d < hw && sp >= 0 && sp < SEQ; const u32x4 w = wv[d + 8]; const float k = ok ? 1.0f : 0.0f;
                a[0] += k * bf_lo(w.x); a[1] += k * bf_hi(w.x); a[2] += k * bf_lo(w.y); a[3] += k * bf_hi(w.y); a[4] += k * bf_lo(w.z); a[5] += k * bf_hi(w.z); a[6] += k * bf_lo(w.w); a[7] += k * bf_hi(w.w); }
        const float inv = 1.0f / (float)(hiq - lo); const u32x4 w0 = *(const u32x4*)(base + (size_t)s * 512);
        a[0] = a[0] * inv - bf_lo(w0.x); a[1] = a[1] * inv - bf_hi(w0.x); a[2] = a[2] * inv - bf_lo(w0.y); a[3] = a[3] * inv - bf_hi(w0.y);
        a[4] = a[4] * inv - bf_lo(w0.z); a[5] = a[5] * inv - bf_hi(w0.z); a[6] = a[6] * inv - bf_lo(w0.w); a[7] = a[7] * inv - bf_hi(w0.w);
        u32x4 w; w.x = cvt_pk_bf16(a[0], a[1]); w.y = cvt_pk_bf16(a[2], a[3]); w.z = cvt_pk_bf16(a[4], a[5]); w.w = cvt_pk_bf16(a[6], a[7]);
        *(u32x4*)(YC + (size_t)tok * 1024 + 512 + l * 8) = w; }
}

__device__ __forceinline__ void carry_phase(const Ctx& F, const float* spart, const float* aL, bf16_t* zs5) {
    if ((F.gw & 15) != 0) return;
    const int task = F.gw >> 4; if (task >= 128) return;
    const int b = task >> 6, dir = (task >> 5) & 1, g = task & 31, p = F.lane;
    const float ar = aL[((dir * 32 + g) * 64 + p) * 2], ai = aL[((dir * 32 + g) * 64 + p) * 2 + 1];
    float hr = 0.f, hi = 0.f;
    const size_t KS = (size_t)512 * 32 * 256;
    for (int jj = 0; jj < 256; jj += 16) {
        float sr[16], si[16];
#pragma unroll
        for (int u = 0; u < 16; ++u) { const int j = dir ? 255 - (jj + u) : jj + u; const int R = b * 256 + j;
            const float* s = spart + ((size_t)R * 32 + g) * 256 + dir * 128 + p;
            sr[u] = (s[0] + s[KS]) + (s[2 * KS] + s[3 * KS]); si[u] = (s[64] + s[KS + 64]) + (s[2 * KS + 64] + s[3 * KS + 64]); }
#pragma unroll
        for (int u = 0; u < 16; ++u) { const int j = dir ? 255 - (jj + u) : jj + u; const int R = b * 256 + j;
            bf16_t* dst = zs5 + ((size_t)(g * 512 + R) * 1280 + 1024 + dir * 128 + p);
            dst[0] = (bf16_t)f2bf(hr); dst[64] = (bf16_t)f2bf(hi);
            const float nr = ar * hr - ai * hi + sr[u], ni = ar * hi + ai * hr + si[u]; hr = nr; hi = ni; }
    }
}

__device__ __forceinline__ void router_phase(const Ctx& F, const bf16_t* h, const float* gain, const float* wr, float* rs, float* aff) {
    LAS float* WT = (LAS float*)F.lds;
    __syncthreads();
    for (int i = F.tid; i < 16384; i += NTHR) { const int d = i >> 4, e = i & 15; const int c = d >> 5, kq = (d >> 3) & 3, half = (d >> 2) & 1, u4 = d & 3;
        WT[((((c * 4 + kq) * 2 + half) * 16 + e) << 2) + u4] = wr[i] * gain[d]; }
    __syncthreads();
    const int i16 = F.lane & 15, kq = F.lane >> 4;
    for (int tile = F.gw; tile < TOK / 16; tile += F.NGW) {
        const u32x4* xr = (const u32x4*)(h + (size_t)(tile * 16 + i16) * DM) + kq;
        const LAS f32x4* wb = (const LAS f32x4*)WT + kq * 32 + i16;
        f32x4 acc = {0.f, 0.f, 0.f, 0.f}; float ss = 0.f;
#pragma unroll 2
        for (int c = 0; c < 32; ++c) {
            const u32x4 w = xr[4 * c]; const f32x4 b0 = wb[c * 128], b1 = wb[c * 128 + 16];
            const float a0 = bf_lo(w.x), a1 = bf_hi(w.x), a2 = bf_lo(w.y), a3 = bf_hi(w.y), a4 = bf_lo(w.z), a5 = bf_hi(w.z), a6 = bf_lo(w.w), a7 = bf_hi(w.w);
            ss += ((a0 * a0 + a1 * a1) + (a2 * a2 + a3 * a3)) + ((a4 * a4 + a5 * a5) + (a6 * a6 + a7 * a7));
            acc = __builtin_amdgcn_mfma_f32_16x16x4f32(a0, b0[0], acc, 0, 0, 0); acc = __builtin_amdgcn_mfma_f32_16x16x4f32(a1, b0[1], acc, 0, 0, 0);
            acc = __builtin_amdgcn_mfma_f32_16x16x4f32(a2, b0[2], acc, 0, 0, 0); acc = __builtin_amdgcn_mfma_f32_16x16x4f32(a3, b0[3], acc, 0, 0, 0);
            acc = __builtin_amdgcn_mfma_f32_16x16x4f32(a4, b1[0], acc, 0, 0, 0); acc = __builtin_amdgcn_mfma_f32_16x16x4f32(a5, b1[1], acc, 0, 0, 0);
            acc = __builtin_amdgcn_mfma_f32_16x16x4f32(a6, b1[2], acc, 0, 0, 0); acc = __builtin_amdgcn_mfma_f32_16x16x4f32(a7, b1[3], acc, 0, 0, 0);
        }
        ss += __shfl_xor(ss, 16); ss += __shfl_xor(ss, 32);
        const float rstd = __builtin_amdgcn_rsqf(ss * (1.f / DM) + EPS);
        if (F.lane < 16) rs[tile * 16 + F.lane] = rstd;
        const int tok0 = tile * 16 + 4 * kq, bq = tok0 >> 14, sq0 = tok0 & (SEQ - 1);
#pragma unroll
        for (int r = 0; r < 4; ++r) { const float lg = acc[r] * __shfl(rstd, 4 * kq + r);
            float mx = lg; mx = fmaxf(mx, __shfl_xor(mx, 1)); mx = fmaxf(mx, __shfl_xor(mx, 2)); mx = fmaxf(mx, __shfl_xor(mx, 4)); mx = fmaxf(mx, __shfl_xor(mx, 8));
            const float ex = __expf(lg - mx); float sm = ex; sm += __shfl_xor(sm, 1); sm += __shfl_xor(sm, 2); sm += __shfl_xor(sm, 4); sm += __shfl_xor(sm, 8);
            aff[((size_t)(bq * 16 + i16)) * SEQ + sq0 + r] = ex / sm; }
    }
    __syncthreads();
}


__device__ __forceinline__ unsigned block_sum_u(unsigned v, LAS unsigned* red, int& flip, int wave, int lane) {
#pragma unroll
    for (int o = 1; o < 64; o <<= 1) v += __shfl_xor(v, o);
    if (lane == 0) red[flip * 8 + wave] = v;
    __syncthreads();
    unsigned t = 0;
#pragma unroll
    for (int w = 0; w < 8; ++w) t += red[flip * 8 + w];
    flip ^= 1; return t;
}
__device__ __forceinline__ unsigned block_excl_scan_u(unsigned v, LAS unsigned* red, int& flip, int wave, int lane) {
    unsigned inc = v;
#pragma unroll
    for (int o = 1; o < 64; o <<= 1) { const unsigned t = __shfl_up(inc, o); if (lane >= o) inc += t; }
    if (lane == 63) red[flip * 8 + wave] = inc;
    __syncthreads();
    unsigned base = 0;
#pragma unroll
    for (int w = 0; w < 8; ++w) base += (w < wave) ? red[flip * 8 + w] : 0u;
    flip ^= 1; return base + inc - v;
}
__device__ __forceinline__ void select_phase(const Ctx& F, const float* aff, int* idx, float* gate, int* slotmap) {
    LAS unsigned* red = (LAS unsigned*)F.lds; int flip = 0;
    for (int pr = F.vcu; pr < 32; pr += F.G) {
        const int b = pr >> 4, e = pr & 15, ge = e * 2 + b;
        const float* src = aff + (size_t)pr * SEQ + F.tid * 32;
        unsigned key[32];
#pragma unroll
        for (int q = 0; q < 8; ++q) { const u32x4 w = *(const u32x4*)(src + q * 4); key[q * 4] = w.x; key[q * 4 + 1] = w.y; key[q * 4 + 2] = w.z; key[q * 4 + 3] = w.w; }
        unsigned lo = 0u, hi = 0x7f800001u;
        while (hi - lo > 1u) { const unsigned mid = lo + ((hi - lo) >> 1); unsigned c = 0;
#pragma unroll
            for (int q = 0; q < 32; ++q) c += (mid - 1u - key[q]) >> 31;
            const unsigned tot = block_sum_u(c, red, flip, F.wave, F.lane);
            if (tot >= (unsigned)CAP) lo = mid; else hi = mid; }
        const unsigned thr = lo; unsigned cgt = 0, ceq = 0;
#pragma unroll
        for (int q = 0; q < 32; ++q) { cgt += (thr - key[q]) >> 31; const unsigned x = key[q] ^ thr; ceq += 1u - (x < 1u ? x : 1u); }
        const unsigned ngt = block_sum_u(cgt, red, flip, F.wave, F.lane);
        const unsigned need = (unsigned)CAP - ngt;
        const unsigned eqr0 = block_excl_scan_u(ceq, red, flip, F.wave, F.lane);
        unsigned csel = 0, eqr = eqr0;
#pragma unroll
        for (int q = 0; q < 32; ++q) { const unsigned gt = (thr - key[q]) >> 31; const unsigned x = key[q] ^ thr; const unsigned eq = 1u - (x < 1u ? x : 1u);
            csel += gt | (eq & ((eqr - need) >> 31)); eqr += eq; }
        unsigned slot = block_excl_scan_u(csel, red, flip, F.wave, F.lane);
        eqr = eqr0;
        int sm[32];
#pragma unroll
        for (int q = 0; q < 32; ++q) { const unsigned gt = (thr - key[q]) >> 31; const unsigned x = key[q] ^ thr; const unsigned eq = 1u - (x < 1u ? x : 1u);
            const unsigned sel = gt | (eq & ((eqr - need) >> 31)); eqr += eq;
            if (sel) { idx[(size_t)ge * CAP + slot] = F.tid * 32 + q; gate[(size_t)ge * CAP + slot] = __uint_as_float(key[q]); }
            sm[q] = sel ? (int)slot : -1; slot += sel; }
        int* smp = slotmap + (size_t)ge * SEQ + F.tid * 32;
#pragma unroll
        for (int q = 0; q < 8; ++q) { i32x4 w; w.x = sm[q * 4]; w.y = sm[q * 4 + 1]; w.z = sm[q * 4 + 2]; w.w = sm[q * 4 + 3]; *(i32x4*)(smp + q * 4) = w; }
    }
    __syncthreads();
}

__device__ __forceinline__ void combine_phase(const Ctx& F, const bf16_t* hin, bf16_t* hout, float* fout, const bf16_t* YB, const int* slotmap, const float* gnext, bf16_t* N) {
    f32x4 g4[4];
#pragma unroll
    for (int j = 0; j < 4; ++j) g4[j] = gnext ? ((const f32x4*)gnext)[F.lane + 64 * j] : (f32x4){0.f, 0.f, 0.f, 0.f};
    int sm_next = -1; if (F.gw < TOK && F.lane < 16) sm_next = slotmap[((size_t)(F.lane * 2 + (F.gw >> 14))) * SEQ + (F.gw & (SEQ - 1))];
    for (int tok = F.gw; tok < TOK; tok += F.NGW) { const int b = tok >> 14;
        const int sm = sm_next; { const int tn = tok + F.NGW; sm_next = -1; if (tn < TOK && F.lane < 16) sm_next = slotmap[((size_t)(F.lane * 2 + (tn >> 14))) * SEQ + (tn & (SEQ - 1))]; }
        unsigned long long mask = __ballot(sm >= 0);
        const u32x2* xr = (const u32x2*)(hin + (size_t)tok * DM) + F.lane; f32x4 v[4]; u32x2 hw[4];
#pragma unroll
        for (int j = 0; j < 4; ++j) hw[j] = xr[64 * j];
        bool first = true;
        do {
            u32x2 y[4][4];
#pragma unroll
            for (int i = 0; i < 4; ++i) { const bool ok = mask != 0ull; const int e = ok ? __builtin_ctzll(mask) : 0; mask &= mask - 1ull; const int slot = __shfl(sm, e);
                const u32x2* yr = (const u32x2*)(YB + ((size_t)(e * 2 + b) * CAP + (ok ? slot : 0)) * DM) + F.lane;
#pragma unroll
                for (int j = 0; j < 4; ++j) y[i][j] = ok ? yr[64 * j] : (u32x2){0u, 0u}; }
            if (first) { first = false;
#pragma unroll
                for (int j = 0; j < 4; ++j) v[j] = (f32x4){bf_lo(hw[j].x), bf_hi(hw[j].x), bf_lo(hw[j].y), bf_hi(hw[j].y)}; }
#pragma unroll
            for (int i = 0; i < 4; ++i)
#pragma unroll
                for (int j = 0; j < 4; ++j) { v[j][0] += bf_lo(y[i][j].x); v[j][1] += bf_hi(y[i][j].x); v[j][2] += bf_lo(y[i][j].y); v[j][3] += bf_hi(y[i][j].y); }
        } while (mask);
        float ss = 0.f;
        if (fout) { f32x4* orow = (f32x4*)(fout + (size_t)tok * DM) + F.lane;
#pragma unroll
            for (int j = 0; j < 4; ++j) orow[64 * j] = v[j]; }
        else { u32x2* orow = (u32x2*)(hout + (size_t)tok * DM) + F.lane;
#pragma unroll
            for (int j = 0; j < 4; ++j) { u32x2 w; w.x = cvt_pk_bf16(v[j][0], v[j][1]); w.y = cvt_pk_bf16(v[j][2], v[j][3]); orow[64 * j] = w; } }
#pragma unroll
        for (int j = 0; j < 4; ++j) { ss += (v[j][0] * v[j][0] + v[j][1] * v[j][1]) + (v[j][2] * v[j][2] + v[j][3] * v[j][3]); }
        if (gnext) { const float rstd = __builtin_amdgcn_rsqf(wave_sum(ss) * (1.f / DM) + EPS); u32x2* o8 = (u32x2*)(N + (size_t)tok * DM) + F.lane;
#pragma unroll
            for (int j = 0; j < 4; ++j) { const f32x4 y = v[j] * rstd * g4[j]; u32x2 w; w.x = cvt_pk_bf16(y[0], y[1]); w.y = cvt_pk_bf16(y[2], y[3]); o8[64 * j] = w; } }
    }
}

#define PHASE_BEGIN unsigned char* ws = (unsigned char*)getp(lds_raw, 32)
#define INF(k) ((const float*)getp(lds_raw, (k)))
#define WSP(T, off) ((T*)(ws + (off)))
#define GRID_BAR() do { unsigned char* wsb_ = (unsigned char*)getp(lds_raw, 32); XcdBarrier bar_; bar_.bar = (unsigned*)(wsb_ + WS_CTL) + CW_BAR; bar_.x = xb_xcc_id(); \
    bar_.st = (volatile LAS unsigned*)((LAS unsigned char*)lds_raw + MISC_OFF) + 8; xcd_barrier(bar_); } while (0)
#define MKCTX() Ctx F; F.lds = (LAS unsigned char*)lds_raw; { int t_ = threadIdx.x; asm volatile("" : "+v"(t_)); F.tid = t_; } F.lane = F.tid & 63; F.wave = __builtin_amdgcn_readfirstlane(F.tid >> 6); \
    F.G = GRID; { int bx = blockIdx.x; asm volatile("" : "+s"(bx)); F.vcu = (bx & 7) * (GRID / 8) + (bx >> 3); } F.gw = F.vcu * NWAVES + F.wave; F.NGW = GRID * NWAVES

__global__ void __launch_bounds__(NTHR, 2) mega_fwd(Params P) {
    extern __shared__ __attribute__((aligned(16))) unsigned char lds_raw[];
    {
        const int tid = threadIdx.x;
        for (int u = tid; u < (LDS_BYTES - LDSCTL_OFF) / 4; u += NTHR) ((LAS unsigned*)((LAS unsigned char*)lds_raw + LDSCTL_OFF))[u] = 0u;
        __syncthreads();
        if (tid == 0) { LAS unsigned long long* tab = (LAS unsigned long long*)((LAS unsigned char*)lds_raw + PTAB_OFF);
#pragma unroll
            for (int k = 0; k < 31; ++k) tab[k] = (unsigned long long)P.in[k];
            tab[31] = (unsigned long long)P.out; tab[32] = (unsigned long long)P.ws; }
        __syncthreads();
        (void)xcd_barrier_post((unsigned*)(P.ws + WS_CTL) + CW_BAR, (volatile LAS unsigned*)((LAS unsigned char*)lds_raw + MISC_OFF) + 8);
    }
    {
        PHASE_BEGIN; MKCTX();
        const int* pos = (const int*)getp(lds_raw, 1); float* COS = WSP(float, WS_COS); float* SIN = WSP(float, WS_SIN); const float* x = INF(0); bf16_t* N = WSP(bf16_t, WS_N);
        const int gt = F.gw * 64 + F.lane, NT = F.NGW * 64;
        for (int it = gt; it < TOK * 32; it += NT) { const int tok = it >> 5, i = it & 31;
            const float inv = __builtin_amdgcn_exp2f(-(float)i * (13.287712379549449f / 32.0f));
            const float ang = (float)pos[tok] * inv; float s, c; sincos_big((double)ang, s, c); COS[it] = c; SIN[it] = s; }
        f32x4 g4[4];
#pragma unroll
        for (int j = 0; j < 4; ++j) g4[j] = ((const f32x4*)INF(2))[F.lane + 64 * j];
        for (int tok = F.gw; tok < TOK; tok += F.NGW) rms_row_to_bf16(x + (size_t)tok * DM, g4, N + (size_t)tok * DM, F.lane);
    }

    for (int l = 0; l < DBG_LAYERS; ++l) {
        const int ev = l >> 1; const bool even = (l & 1) == 0;
        if (PH(0)) REP(0) {
            PHASE_BEGIN; MKCTX();
            const bool s5blk = even && F.vcu < 32;
            const int w0 = even ? F.gw - 32 * NWAVES : F.gw, nw = even ? F.NGW - 32 * NWAVES : F.NGW;
            if (s5blk) s5_prep1(F, lds_raw, ev, WSP(bf16_t, WS_WST), WSP(bf16_t, WS_BTM), WSP(float, WS_KBUF), WSP(float, WS_AL));
            else {
                moe_weight_prep(F, INF(28) + (size_t)l * 16 * 1024 * 2048, INF(29) + (size_t)l * 16 * 1024 * 2048, INF(30) + (size_t)l * 16 * 2048 * 1024, INF(3) + (size_t)l * DM, WSP(bf16_t, WS_BT1), WSP(bf16_t, WS_BT2), w0, nw, MOE_PREP_HEAD);
                if (even) {
                    weight_prep(F, INF(4) + (size_t)ev * 1024 * 1024, 1024, 1024, WSP(bf16_t, WS_WIN), w0, nw);
                    weight_prep(F, INF(5) + (size_t)ev * 1024 * 1024, 1024, 1024, WSP(bf16_t, WS_WOUT), w0, nw);
                    glupool_prep(F, INF(14) + (size_t)ev * 512 * 512, INF(16) + (size_t)ev * 4 * 128 * 128, WSP(bf16_t, WS_WGP), w0, nw);
                } else {
                    weight_prep<RmQK>(F, INF(18) + (size_t)ev * 1024 * 3072, 1024, 3072, WSP(bf16_t, WS_WIN), w0, nw);
                    weight_prep(F, INF(19) + (size_t)ev * 1024 * 1024, 1024, 1024, WSP(bf16_t, WS_WOUT), w0, nw);
                }
            }
        }
        GRID_BAR();
#if DBG_MIX
        if (even) {
            if (PH(1)) REP(1) {
                { PHASE_BEGIN; MKCTX(); s5_prep2(F, WSP(float, WS_KBUF), WSP(bf16_t, WS_BTM)); }
                {
                    PHASE_BEGIN; MKCTX();
                    pg8::Cfg g{2048u, 2048u, 1024}; pg8::PlainOrder S; S.init(TOK, 1024, GRID, (int)blockIdx.x, WSP(bf16_t, WS_N), WSP(bf16_t, WS_WIN), 2048u, 2048u);
                    pg8::EpiZ E{WSP(bf16_t, WS_ZS5), WSP(bf16_t, WS_ZP)};
                    pg8::gemm_phase(F.lds, g, S, E);
                }
            }
            GRID_BAR();
            if (PH(2)) REP(2) {
                {
                    PHASE_BEGIN; MKCTX();
                    pg8::Cfg g{2560u, 2048u, 256}; pg8::S5Order S{GRID, F.vcu, (const char*)WSP(bf16_t, WS_ZS5), (const char*)WSP(bf16_t, WS_WST), (size_t)512 * 2560, (size_t)256 * 2560, (size_t)256 * 2048, 512, 512};
                    pg8::EpiState E{WSP(float, WS_SPART)};
                    pg8::gemm_phase(F.lds, g, S, E);
                }
            }
            GRID_BAR();
            if (PH(3)) REP(3) { PHASE_BEGIN; MKCTX();
                if ((F.gw & 15) == 0) carry_phase(F, WSP(float, WS_SPART), WSP(float, WS_AL), WSP(bf16_t, WS_ZS5));
                else pool_phase(F, WSP(bf16_t, WS_ZP), WSP(bf16_t, WS_YC), F.gw - (F.gw >> 4) - 1, F.NGW - F.NGW / 16); }
            GRID_BAR();
            if (PH(4)) REP(4) {
                PHASE_BEGIN; MKCTX();
                pg8::Cfg g{2560u, 2560u, 1280}; pg8::S5Order S{GRID, F.vcu, (const char*)WSP(bf16_t, WS_ZS5), (const char*)WSP(bf16_t, WS_BTM), (size_t)512 * 2560, (size_t)256 * 2560, (size_t)1024 * 2560, 0, (size_t)256 * 2560};
                pg8::EpiS5 E{WSP(bf16_t, WS_ZS5), INF(13) + (size_t)ev * 512, WSP(bf16_t, WS_YC)};
                pg8::gemm_phase(F.lds, g, S, E);
            }
            GRID_BAR();
            if (PH(5)) REP(5) {
                PHASE_BEGIN; MKCTX();
                pg8::Cfg g{2048u, 1024u, 512}; pg8::PlainOrder S; S.init(TOK, 1024, GRID, (int)blockIdx.x, WSP(bf16_t, WS_YC), WSP(bf16_t, WS_WGP), 2048u, 1024u); S.a_pn_split = 2; S.a_pn_off = 1024;
                pg8::EpiGluPool E{WSP(bf16_t, WS_YC), INF(15) + (size_t)ev * 512, INF(17) + (size_t)ev * 512, WSP(bf16_t, WS_MIX)};
                pg8::gemm_phase(F.lds, g, S, E);
            }
            GRID_BAR();
        } else {
            if (PH(6)) REP(6) {
                PHASE_BEGIN; MKCTX();
                pg8::Cfg g{2048u, 2048u, 1024}; pg8::PlainOrder S; S.init(TOK, 3072, GRID, (int)blockIdx.x, WSP(bf16_t, WS_N), WSP(bf16_t, WS_WIN), 2048u, 2048u);
                pg8::EpiQKV E{WSP(bf16_t, WS_Q), (size_t)(WS_K - WS_Q) / 2, WSP(float, WS_COS), WSP(float, WS_SIN), INF(20) + ev * 64, INF(21) + ev * 64, (LAS float*)(F.lds + GTAB_OFF)};
                pg8::gemm_phase(F.lds, g, S, E);
            }
            GRID_BAR();
            if (PH(8)) REP(8) {
                PHASE_BEGIN; MKCTX();
                const float lam_init = 0.8f - 0.6f * __expf(-0.3f * (float)l);
                const float d1 = wave_sum(INF(22)[ev * 64 + F.lane] * INF(23)[ev * 64 + F.lane]);
                const float d2 = wave_sum(INF(24)[ev * 64 + F.lane] * INF(25)[ev * 64 + F.lane]);
                const float lam = __expf(d1) - __expf(d2) + lam_init;
                const bf16_t* QB = WSP(bf16_t, WS_Q); const bf16_t* KB = WSP(bf16_t, WS_K); const bf16_t* VB = WSP(bf16_t, WS_V); bf16_t* MIX = WSP(bf16_t, WS_MIX); const float* subg = INF(26) + ev * 128;
                bf16x8 qr[2][2] = {};
                for (int i = 0;; ++i) { const int u = i * GRID + F.vcu; if (u >= BATCH * 8 * 128) break;
                    const int bh = u >> 7, qb = u & 127, un = u + GRID, bhn = un >> 7;
                    att::attn_unit16(F.lds, QB, KB, VB, MIX, bh >> 3, bh & 7, qb, lam, 1.0f - lam_init, subg, qr, i == 0, un < BATCH * 8 * 128, bhn >> 3, bhn & 7); }
            }
            GRID_BAR();
        }
        if (PH(9)) REP(9) {
            PHASE_BEGIN; MKCTX();
            pg8::Cfg g{2048u, 2048u, 1024}; pg8::PlainOrder S; S.init(TOK, 1024, GRID, (int)blockIdx.x, WSP(bf16_t, WS_MIX), WSP(bf16_t, WS_WOUT), 2048u, 2048u);
            pg8::EpiResB E{(l == 0) ? INF(0) : (const float*)nullptr, WSP(bf16_t, WS_H), WSP(bf16_t, WS_H)};
            pg8::gemm_phase(F.lds, g, S, E);
        }
        GRID_BAR();
#else
        if (l == 0) { PHASE_BEGIN; MKCTX(); const int gt = F.gw * 64 + F.lane, NT = F.NGW * 64; for (int it = gt; it < TOK * DM / 4; it += NT) WSP(f32x4, WS_H)[it] = ((const f32x4*)INF(0))[it]; GRID_BAR(); }
#endif
#if DBG_MOE
        if (PH(10)) REP(10) { PHASE_BEGIN; MKCTX(); router_phase(F, WSP(bf16_t, WS_H), INF(3) + (size_t)l * DM, INF(27) + (size_t)l * DM * NE, WSP(float, WS_RSMOE), WSP(float, WS_AFF)); }
        GRID_BAR();
        if (PH(11)) REP(11) { PHASE_BEGIN; MKCTX();
            if (F.vcu < 32) select_phase(F, WSP(float, WS_AFF), WSP(int, WS_IDX), WSP(float, WS_GATE), WSP(int, WS_SLOT));
            else moe_weight_prep(F, INF(28) + (size_t)l * 16 * 1024 * 2048, INF(29) + (size_t)l * 16 * 1024 * 2048, INF(30) + (size_t)l * 16 * 2048 * 1024, INF(3) + (size_t)l * DM, WSP(bf16_t, WS_BT1), WSP(bf16_t, WS_BT2), MOE_PREP_HEAD + F.gw - 32 * NWAVES, F.NGW - 32 * NWAVES); }
        GRID_BAR();
        for (int hf = 0; hf < 2; ++hf) {
        if (PH(13)) REP(13) { PHASE_BEGIN; MKCTX();
            LAS unsigned* gt = (LAS unsigned*)(F.lds + GTAB_OFF); const int* idx = WSP(int, WS_IDX);
            const int pml = ((F.vcu >> 5) >> 1) * 4 + ((F.vcu & 31) >> 3);
            for (int j = F.tid; j < 8 * 256; j += NTHR) { const int pm = (8 * hf + (j >> 8)) * 16 + pml, bq = (pm >> 3) & 1; const int tk = bq * SEQ + idx[pm * 256 + (j & 255)]; gt[j] = (unsigned)tk * 2048u; ((LAS float*)(gt + 2048))[j] = WSP(float, WS_RSMOE)[tk]; }
            __syncthreads();
            pg8::Cfg g{2048u, 2048u, 1024}; pg8::Moe1Order S{GRID, F.vcu, (const char*)WSP(bf16_t, WS_H), (const char*)WSP(bf16_t, WS_BT1), 8 * hf, 8};
            pg8::EpiSwiglu E{WSP(bf16_t, WS_HMID), (const LAS float*)(gt + 2048)};
            pg8::gemm_phase<pg8::EpiSwiglu, pg8::Moe1Order, true>(F.lds, g, S, E, gt); }
        GRID_BAR();
        if (PH(14)) REP(14) { PHASE_BEGIN; MKCTX(); pg8::Cfg g{4096u, 4096u, 2048}; pg8::Moe2Order S{GRID, F.vcu, (const char*)WSP(bf16_t, WS_HMID), (const char*)WSP(bf16_t, WS_BT2), 8 * hf, 8};
            pg8::EpiGate E{WSP(bf16_t, WS_YB), WSP(float, WS_GATE)};
            pg8::gemm_phase(F.lds, g, S, E); }
        GRID_BAR();
        }
        if (PH(15)) REP(15) { PHASE_BEGIN; MKCTX(); combine_phase(F, WSP(bf16_t, WS_H), WSP(bf16_t, WS_H), (l == 3) ? (float*)getp(lds_raw, 31) : (float*)nullptr, WSP(bf16_t, WS_YB), WSP(int, WS_SLOT), (l < 3) ? INF(2) + (size_t)(l + 1) * DM : nullptr, WSP(bf16_t, WS_N)); }
#else
        {
            PHASE_BEGIN; MKCTX();
            const float* gnext = (l < 3) ? INF(2) + (size_t)(l + 1) * DM : nullptr; float* H = WSP(float, WS_H); bf16_t* N = WSP(bf16_t, WS_N);
            f32x4 g4[4];
#pragma unroll
            for (int j = 0; j < 4; ++j) g4[j] = gnext ? ((const f32x4*)gnext)[F.lane + 64 * j] : (f32x4){0.f, 0.f, 0.f, 0.f};
            if (gnext) for (int tok = F.gw; tok < TOK; tok += F.NGW) rms_row_to_bf16(H + (size_t)tok * DM, g4, N + (size_t)tok * DM, F.lane);
            if (l == 3) { const int gt = F.gw * 64 + F.lane, NT = F.NGW * 64; for (int it = gt; it < TOK * DM / 4; it += NT) ((f32x4*)getp(lds_raw, 31))[it] = ((const f32x4*)H)[it]; }
            GRID_BAR();
        }
#endif
    }
#if DBG_LAYERS < 4
    {   PHASE_BEGIN; MKCTX(); const int gt = F.gw * 64 + F.lane, NT = F.NGW * 64; const float* src = (DBG_LAYERS == 0) ? INF(0) : (const float*)WSP(float, WS_H);
        for (int it = gt; it < TOK * DM / 4; it += NT) ((f32x4*)getp(lds_raw, 31))[it] = ((const f32x4*)src)[it]; }
#endif
}

extern "C" void kernel_launch(void* const* d_in, const int* in_sizes, int n_in, void* d_out, int out_size, void* d_ws, size_t ws_size, hipStream_t stream) {
    static int grid = 0;
    if (grid == 0) {
        if (n_in != 31 || out_size != TOK * DM || ws_size < WS_END) { fprintf(stderr, "kernel_launch: unexpected shapes: n_in %d out %d ws %zu (need %zu)\n", n_in, out_size, ws_size, (size_t)WS_END); grid = -1; return; }
        int dev = 0, cus = 0, per_cu = 0;
        if (hipGetDevice(&dev) != hipSuccess || hipDeviceGetAttribute(&cus, hipDeviceAttributeMultiprocessorCount, dev) != hipSuccess) { grid = -1; return; }
        if (hipFuncSetAttribute((const void*)mega_fwd, hipFuncAttributeMaxDynamicSharedMemorySize, LDS_BYTES) != hipSuccess) { fprintf(stderr, "kernel_launch: hipFuncSetAttribute failed\n"); grid = -1; return; }
        if (hipOccupancyMaxActiveBlocksPerMultiprocessor(&per_cu, (const void*)mega_fwd, NTHR, LDS_BYTES) != hipSuccess || per_cu < 1)
            fprintf(stderr, "kernel_launch: note: occupancy query reports %d workgroups per CU\n", per_cu);
        (void)hipGetLastError();
        if (cus < GRID) { fprintf(stderr, "kernel_launch: this kernel needs %d CUs (device has %d)\n", GRID, cus); grid = -1; return; }
        grid = GRID;
    }
    if (grid < 0) return;
    if (hipMemsetAsync((char*)d_ws + WS_CTL, 0, CTL_ZERO_BYTES, stream) != hipSuccess) { fprintf(stderr, "kernel_launch: memset failed\n"); return; }
    Params p{};
    for (int i = 0; i < 31; ++i) p.in[i] = d_in[i];
    p.out = (float*)d_out; p.ws = (unsigned char*)d_ws;
    hipLaunchKernelGGL(mega_fwd, dim3(grid), dim3(NTHR), LDS_BYTES, stream, p);
    const hipError_t le = hipPeekAtLastError();
    if (le != hipSuccess) fprintf(stderr, "kernel_launch: launch failed: %s\n", hipGetErrorName(le));
}
```
